# Optimizing an MI355X kernel written in HIP

```python
import jax, jax.numpy as jnp
from jax import lax

D_MODEL = 1024
BATCH = 8
SEQ = 4096
DEPTH = 4

N_HEADS = 16
HEAD_DIM = 128
D_INNER = N_HEADS * HEAD_DIM
Q_BLOCK = 128
N_MIXERS = 2
LN_EPS = 1e-5
DEEPNORM_ALPHA = (2 * DEPTH) ** 0.25
DEEPNORM_BETA = (8 * DEPTH) ** -0.25
FOX_COLS = 4 * D_INNER + N_HEADS
SB_COLS = 4 * D_INNER
N_FOX = (DEPTH + 1) // 2
N_SB = DEPTH // 2

kernel_name = "fox_stickbreaking_interleaved_deepnorm"


def _to_blocks(t):
    b, s = t.shape[:2]
    t = t.reshape((b, s // Q_BLOCK, Q_BLOCK) + t.shape[2:])
    return jnp.moveaxis(t, 1, 0)


def _from_blocks(t):
    nb, b, qb = t.shape[:3]
    return jnp.moveaxis(t, 0, 1).reshape(b, nb * qb, -1)


def forgetting_attention(q, k, v, log_f):
    s = q.shape[1]
    scale = HEAD_DIM ** -0.5
    cum = jnp.cumsum(log_f, axis=1)
    cum_k = jnp.transpose(cum, (0, 2, 1))
    k_pos = jnp.arange(s)

    def one_block(args):
        q_blk, c_blk, blk = args
        q_pos = blk * Q_BLOCK + jnp.arange(Q_BLOCK)
        logits = jnp.einsum('bqhd,bkhd->bhqk', q_blk, k) * scale
        logits = logits + jnp.transpose(c_blk, (0, 2, 1))[..., None] - cum_k[:, :, None, :]
        causal = k_pos[None, :] <= q_pos[:, None]
        logits = jnp.where(causal, logits, -jnp.inf)
        p = jax.nn.softmax(logits, axis=-1)
        return jnp.einsum('bhqk,bkhd->bqhd', p, v)

    nb = s // Q_BLOCK
    out = lax.map(one_block, (_to_blocks(q), _to_blocks(cum), jnp.arange(nb)))
    return _from_blocks(out)


def stick_breaking_attention(q, k, v):
    s = q.shape[1]
    scale = HEAD_DIM ** -0.5
    k_pos = jnp.arange(s)

    def one_block(args):
        q_blk, blk = args
        q_pos = blk * Q_BLOCK + jnp.arange(Q_BLOCK)
        z = jnp.einsum('bqhd,bkhd->bhqk', q_blk, k) * scale
        strict = k_pos[None, :] < q_pos[:, None]
        log_one_minus = jnp.where(strict, jax.nn.log_sigmoid(-z), 0.0)
        remain = lax.cumsum(log_one_minus, axis=3, reverse=True) - log_one_minus
        weights = jnp.where(strict, jnp.exp(jax.nn.log_sigmoid(z) + remain), 0.0)
        return jnp.einsum('bhqk,bkhd->bqhd', weights, v)

    nb = s // Q_BLOCK
    out = lax.map(one_block, (_to_blocks(q), jnp.arange(nb)))
    return _from_blocks(out)


def _layer_norm(x, g, b):
    xf = x.astype(jnp.float32)
    mu = jnp.mean(xf, axis=-1, keepdims=True)
    var = jnp.mean(jnp.square(xf - mu), axis=-1, keepdims=True)
    y = (xf - mu) * lax.rsqrt(var + LN_EPS) * g.astype(jnp.float32) + b.astype(jnp.float32)
    return y.astype(x.dtype)


def setup_inputs(seed: int = 0) -> dict:
    key = jax.random.key(seed)
    ks = jax.random.split(key, 8)
    x = jax.random.normal(ks[0], (BATCH, SEQ, D_MODEL), jnp.float32)

    fox_scale = jnp.ones((FOX_COLS,), jnp.float32).at[2 * D_INNER:3 * D_INNER].set(DEEPNORM_BETA)
    sb_scale = jnp.ones((SB_COLS,), jnp.float32).at[2 * D_INNER:3 * D_INNER].set(DEEPNORM_BETA)
    fox_w_in = jax.random.normal(ks[1], (N_FOX, D_MODEL, FOX_COLS), jnp.float32) * (D_MODEL ** -0.5) * fox_scale
    sb_w_in = jax.random.normal(ks[2], (N_SB, D_MODEL, SB_COLS), jnp.float32) * (D_MODEL ** -0.5) * sb_scale
    fox_b_f = jax.random.uniform(ks[3], (N_FOX, N_HEADS), jnp.float32, minval=1.0, maxval=4.0)
    out_std = (D_INNER ** -0.5) * DEEPNORM_BETA
    fox_w_out = jax.random.normal(ks[4], (N_FOX, D_INNER, D_MODEL), jnp.float32) * out_std
    sb_w_out = jax.random.normal(ks[5], (N_SB, D_INNER, D_MODEL), jnp.float32) * out_std
    ln_g = 1.0 + 0.02 * jax.random.normal(ks[6], (DEPTH, D_MODEL), jnp.float32)
    ln_b = 0.02 * jax.random.normal(ks[7], (DEPTH, D_MODEL), jnp.float32)
    return {"x": x, "fox_w_in": fox_w_in, "fox_b_f": fox_b_f, "fox_w_out": fox_w_out,
            "sb_w_in": sb_w_in, "sb_w_out": sb_w_out, "ln_g": ln_g, "ln_b": ln_b}


def reference(x, fox_w_in, fox_b_f, fox_w_out, sb_w_in, sb_w_out, ln_g, ln_b):
    b, s, _ = x.shape
    for layer in range(DEPTH):
        slot = layer // N_MIXERS
        use_fox = (layer % N_MIXERS) == 0
        w_in = fox_w_in[slot] if use_fox else sb_w_in[slot]
        w_out = fox_w_out[slot] if use_fox else sb_w_out[slot]

        h = x @ w_in
        q = h[..., 0 * D_INNER:1 * D_INNER].reshape(b, s, N_HEADS, HEAD_DIM).astype(jnp.float32)
        k = h[..., 1 * D_INNER:2 * D_INNER].reshape(b, s, N_HEADS, HEAD_DIM).astype(jnp.float32)
        v = h[..., 2 * D_INNER:3 * D_INNER].reshape(b, s, N_HEADS, HEAD_DIM).astype(jnp.float32)
        z = h[..., 3 * D_INNER:4 * D_INNER]

        if use_fox:
            f_logit = h[..., 4 * D_INNER:].astype(jnp.float32)
            log_f = jax.nn.log_sigmoid(f_logit + fox_b_f[slot].astype(jnp.float32))
            o = forgetting_attention(q, k, v, log_f)
        else:
            o = stick_breaking_attention(q, k, v)

        y = (o.astype(x.dtype) * jax.nn.silu(z)) @ w_out
        x = _layer_norm(DEEPNORM_ALPHA * x + y, ln_g[layer], ln_b[layer])
    return x
```

```cpp
#include <hip/hip_runtime.h>
#include <hip/hip_cooperative_groups.h>
#include <cstdio>
#include <cstdint>
namespace cg = cooperative_groups;
__device__ __forceinline__ int otid() { int t = threadIdx.x; asm volatile("" : "+v"(t)); return t; }
__device__ __forceinline__ int obid() { int t = blockIdx.x; asm volatile("" : "+s"(t)); return t; }
__device__ __forceinline__ int ogrid() { int t = gridDim.x; asm volatile("" : "+s"(t)); return t; }
namespace pg8 {
#define PG8_LAS __attribute__((address_space(3)))
typedef unsigned short bf16_t;
typedef short bf16x8 __attribute__((ext_vector_type(8)));
typedef float f32x4 __attribute__((ext_vector_type(4)));
typedef unsigned u32x4 __attribute__((ext_vector_type(4)));
constexpr int BM = 256, BK = 64, HALF = 128, HTB = HALF * BK * 2  , STAGE_BYTES = 8 * HTB, NXCD = 8, WGM = 8;

__host__ __device__ __forceinline__ int lds_byte(int r, int c) { const int st = (r >> 4) * 2 + (c >> 5), rr = r & 15, cc = c & 31, ob = rr * 64 + cc * 2; return st * 1024 + (ob ^ (((ob >> 9) & 1) << 5)); }
__host__ __device__ __forceinline__ void stage_rc(int b, int& R, int& C) { const int st = b / 1024, sb = b % 1024, swz = sb ^ (((sb >> 9) & 1) << 5); R = (st >> 1) * 16 + swz / 64; C = (st & 1) * 32 + (swz % 64) / 2; }
__host__ __device__ __forceinline__ int perm32(int rho) { const int n = rho >> 4, i = rho & 15; return 8 * (i >> 2) + 4 * n + (i & 3); }

struct Unit { int pm, pn; };
struct Gemm { const bf16_t* A; const bf16_t* Bt; int M, N, K; };

struct StaticOrder {
    int nM, nN, nwg, G, c;
    __host__ __device__ void init(int M, int N, int G_, int c_) { nM = M / BM; nN = N / BM; nwg = nM * nN; G = G_; c = c_; }
    __host__ __device__ bool next(int i, Unit& u) const {
        const long L = (long)i * G + c; if (L >= nwg) return false;
        int wgid = (int)L; { const int q = nwg / NXCD, r = nwg % NXCD, xcd = wgid % NXCD, off = wgid / NXCD; wgid = (xcd < r ? xcd * (q + 1) : r * (q + 1) + (xcd - r) * q) + off; }
        const int nig = WGM * nN, gid = wgid / nig, fm = gid * WGM, gsz = (nM - fm) < WGM ? (nM - fm) : WGM;
        u.pm = fm + ((wgid % nig) % gsz); u.pn = (wgid % nig) / gsz; return true;
    }
    __device__ __forceinline__ void a_ready(const Unit&) const {}
    __device__ __forceinline__ void done(const Unit&) const {}
};

__device__ __forceinline__ unsigned cvt_pk_bf16(float lo, float hi) { unsigned r; asm volatile("v_cvt_pk_bf16_f32 %0, %1, %2" : "=v"(r) : "v"(lo), "v"(hi)); return r; }
struct EpiQKVZ {
    static constexpr bool PERM = true, AFTER_DRAIN = false;
    bf16_t* O; size_t wstride; float qscale;
    __device__ __forceinline__ void operator()(const f32x4 (&acc)[2][2][4][2], const Unit& u, int wr, int wc, int fr, int fq) const {
        const int row0 = u.pm * BM + wr * 64 + fr; const int colt = u.pn * BM; const int which = colt >> 11; const int head0 = (colt & 2047) >> 7;
        const int d0 = wc * 32 + 8 * fq; bf16_t* base = O + (size_t)which * wstride;
#pragma unroll
        for (int ai = 0; ai < 2; ++ai)
#pragma unroll
            for (int m = 0; m < 4; ++m) { const int r = row0 + ai * HALF + m * 16; const int b = r >> 12, s = r & 4095;
#pragma unroll
                for (int bj = 0; bj < 2; ++bj) { bf16_t* ptr = base + ((size_t)((b * 16 + head0 + bj) * 4096 + s)) * 128 + d0;
                    f32x4 v0 = acc[ai][bj][m][0], v1 = acc[ai][bj][m][1];
                    if (which == 0) { v0 = v0 * qscale; v1 = v1 * qscale; }
                    if (which == 3) {
#pragma unroll
                        for (int j = 0; j < 4; ++j) { v0[j] = v0[j] * __builtin_amdgcn_rcpf(1.0f + __builtin_amdgcn_exp2f(-1.4426950408889634f * v0[j]));
                                                      v1[j] = v1[j] * __builtin_amdgcn_rcpf(1.0f + __builtin_amdgcn_exp2f(-1.4426950408889634f * v1[j])); } }
                    u32x4 w; w.x = cvt_pk_bf16(v0[0], v0[1]); w.y = cvt_pk_bf16(v0[2], v0[3]); w.z = cvt_pk_bf16(v1[0], v1[1]); w.w = cvt_pk_bf16(v1[2], v1[3]);
                    *(u32x4*)ptr = w; } }
    }
};
struct EpiRes {
    static constexpr bool PERM = false, AFTER_DRAIN = false;
    const float* xres; float* out; float alpha;
    __device__ __forceinline__ void operator()(const f32x4 (&acc)[2][2][4][2], const Unit& u, int wr, int wc, int fr, int fq) const {
        const int row0 = u.pm * BM + wr * 64 + fr; const int col0 = u.pn * BM + wc * 32 + 4 * fq;
#pragma unroll
        for (int ai = 0; ai < 2; ++ai)
#pragma unroll
            for (int m = 0; m < 4; ++m) { const size_t ro = (size_t)(row0 + ai * HALF + m * 16) * 1024;
#pragma unroll
                for (int bj = 0; bj < 2; ++bj)
#pragma unroll
                    for (int n = 0; n < 2; ++n) { const size_t o = ro + col0 + bj * HALF + 16 * n;
                        const f32x4 xr = *(const f32x4*)(xres + o); *(f32x4*)(out + o) = xr * alpha + acc[ai][bj][m][n]; } }
    }
};

template <class Epi, class Sched, bool ALIGN_EPI = false, bool SP2 = false>
__device__ __forceinline__ void gemm_phase(PG8_LAS unsigned char* lds, const Gemm g, const Sched& S, const Epi& E) {
    const int tid = otid(), wid = __builtin_amdgcn_readfirstlane(tid >> 6), lane = tid & 63, wr = wid >> 2, wc = wid & 3, fr = lane & 15, fq = lane >> 4;
    const int K = g.K, nt = K / BK;
    unsigned voffA[2], voffB[2];
#pragma unroll
    for (int i = 0; i < 2; ++i) { int R, C; stage_rc(tid * 16 + i * 8192, R, C); const int Rb = Epi::PERM ? ((R & ~31) + perm32(R & 31)) : R;
        voffA[i] = (unsigned)(R * K + C) * 2u; voffB[i] = (unsigned)(Rb * K + C) * 2u; }
    const size_t kstep = (size_t)(BK * 2);
    const size_t hstep = (size_t)HALF * K * 2;
    const size_t tstep = 2 * hstep;
    const unsigned ldsw = (unsigned)wid * 1024u;
    const int aoff = lds_byte(wr * 64 + fr, fq * 8), boff = lds_byte(wc * 32 + fr, fq * 8);
#define PG8_SA(b, h) (((b) * 2 + (h)) * HTB)
#define PG8_SB(b, h) ((4 + (b) * 2 + (h)) * HTB)
#define PG8_STAGE(bufoff, gbase, voff) do { _Pragma("unroll") for (int _i = 0; _i < 2; ++_i) \
        __builtin_amdgcn_global_load_lds((const unsigned*)((const char*)(gbase) + (voff)[_i]), (PG8_LAS unsigned*)(lds + (bufoff) + ldsw + _i * 8192), 16, 0, 0); } while (0)
#define PG8_LDA(dst, b, h) do { _Pragma("unroll") for (int m = 0; m < 4; ++m) _Pragma("unroll") for (int k = 0; k < 2; ++k) dst[m][k] = *(const PG8_LAS bf16x8*)(lds + PG8_SA(b, h) + aoff + m * 2048 + k * 1024); } while (0)
#define PG8_LDB(dst, b, h) do { _Pragma("unroll") for (int n = 0; n < 2; ++n) _Pragma("unroll") for (int k = 0; k < 2; ++k) dst[n][k] = *(const PG8_LAS bf16x8*)(lds + PG8_SB(b, h) + boff + n * 2048 + k * 1024); } while (0)
#define PG8_MMA(ai, bj, At, Bt) do { __builtin_amdgcn_s_setprio(1); _Pragma("unroll") for (int m = 0; m < 4; ++m) _Pragma("unroll") for (int n = 0; n < 2; ++n) _Pragma("unroll") for (int k = 0; k < 2; ++k) \
        acc[ai][bj][m][n] = __builtin_amdgcn_mfma_f32_16x16x32_bf16(Bt[n][k], At[m][k], acc[ai][bj][m][n], 0, 0, 0); __builtin_amdgcn_s_setprio(0); } while (0)
#define PG8_WAIT_V(n) asm volatile("s_waitcnt vmcnt(" #n ")" ::: "memory")
#define PG8_WAIT_L(n) asm volatile("s_waitcnt lgkmcnt(" #n ")" ::: "memory")
#define PG8_BAR __builtin_amdgcn_s_barrier()
#define PG8_SCHED __builtin_amdgcn_sched_barrier(0)
    Unit cur, nxt; int ui = 0;
    if (!S.next(0, cur)) return;
    f32x4 acc[2][2][4][2];
#pragma unroll
    for (int a = 0; a < 2; ++a)
#pragma unroll
        for (int b = 0; b < 2; ++b)
#pragma unroll
            for (int m = 0; m < 4; ++m)
#pragma unroll
                for (int n = 0; n < 2; ++n) acc[a][b][m][n] = (f32x4){0.f, 0.f, 0.f, 0.f};
    bf16x8 At[4][2], B0[2][2], B1[2][2];
    const char* cA = (const char*)g.A + (size_t)cur.pm * tstep; const char* cB = (const char*)g.Bt + (size_t)cur.pn * tstep;
    S.a_ready(cur);
    if constexpr (SP2) {
        PG8_STAGE(PG8_SB(0, 0), cB, voffB); PG8_STAGE(PG8_SB(0, 1), cB + hstep, voffB); PG8_STAGE(PG8_SA(0, 0), cA, voffA); PG8_STAGE(PG8_SA(0, 1), cA + hstep, voffA);
        if (wr == 1) PG8_BAR;
        PG8_WAIT_V(2); PG8_BAR;
        PG8_STAGE(PG8_SB(1, 0), cB + kstep, voffB); PG8_STAGE(PG8_SA(1, 0), cA + kstep, voffA); PG8_STAGE(PG8_SB(1, 1), cB + hstep + kstep, voffB);
        PG8_WAIT_V(6); PG8_BAR;
    } else {
        PG8_STAGE(PG8_SB(0, 0), cB, voffB); PG8_STAGE(PG8_SA(0, 0), cA, voffA); PG8_STAGE(PG8_SB(0, 1), cB + hstep, voffB); PG8_STAGE(PG8_SA(0, 1), cA + hstep, voffA);
        if (wr == 1) PG8_BAR;
        PG8_WAIT_V(4); PG8_BAR;
        PG8_STAGE(PG8_SB(1, 0), cB + kstep, voffB); PG8_STAGE(PG8_SA(1, 0), cA + kstep, voffA); PG8_STAGE(PG8_SB(1, 1), cB + hstep + kstep, voffB);
        PG8_WAIT_V(6); PG8_BAR;
    }
    for (;;) {
        const bool has_next = S.next(ui + 1, nxt);
        const char* nA = has_next ? (const char*)g.A + (size_t)nxt.pm * tstep : cA; const char* nB = has_next ? (const char*)g.Bt + (size_t)nxt.pn * tstep : cB;
        for (int t = 0; t < nt; t += 2) {
            const bool last = (t == nt - 2);
            const char* a1 = cA + (size_t)(t + 1) * kstep;
            const char* a2 = last ? nA : cA + (size_t)(t + 2) * kstep; const char* b2 = last ? nB : cB + (size_t)(t + 2) * kstep;
            const char* a3 = a2 + kstep; const char* b3 = b2 + kstep;
            if (last && has_next) S.a_ready(nxt);
            if constexpr (SP2) {
            PG8_LDB(B0, 0, 0); PG8_LDB(B1, 0, 1); PG8_SCHED; PG8_LDA(At, 0, 0); PG8_STAGE(PG8_SA(1, 1), a1 + hstep, voffA);
            PG8_WAIT_V(8); PG8_WAIT_L(0); PG8_BAR; PG8_MMA(0, 0, At, B0); PG8_MMA(0, 1, At, B1); PG8_BAR; PG8_SCHED;
            PG8_LDA(At, 0, 1); PG8_STAGE(PG8_SB(0, 0), b2, voffB); PG8_STAGE(PG8_SB(0, 1), b2 + hstep, voffB); PG8_STAGE(PG8_SA(0, 0), a2, voffA);
            PG8_WAIT_V(8); PG8_WAIT_L(0); PG8_BAR; PG8_MMA(1, 0, At, B0); PG8_MMA(1, 1, At, B1); PG8_BAR; PG8_SCHED;
            PG8_LDB(B0, 1, 0); PG8_LDB(B1, 1, 1); PG8_SCHED; PG8_LDA(At, 1, 0); PG8_STAGE(PG8_SA(0, 1), a2 + hstep, voffA);
            PG8_WAIT_V(8); PG8_WAIT_L(0); PG8_BAR; PG8_MMA(0, 0, At, B0); PG8_MMA(0, 1, At, B1); PG8_BAR; PG8_SCHED;
            PG8_LDA(At, 1, 1); PG8_STAGE(PG8_SB(1, 0), b3, voffB); PG8_STAGE(PG8_SB(1, 1), b3 + hstep, voffB); PG8_STAGE(PG8_SA(1, 0), a3, voffA);
            PG8_WAIT_V(8); PG8_WAIT_L(0); PG8_BAR; PG8_MMA(1, 0, At, B0); PG8_MMA(1, 1, At, B1); PG8_BAR; PG8_SCHED;
            } else {
            PG8_LDB(B0, 0, 0); PG8_SCHED; PG8_LDA(At, 0, 0); PG8_STAGE(PG8_SA(1, 1), a1 + hstep, voffA);
            PG8_WAIT_L(8); PG8_BAR; PG8_WAIT_L(0); PG8_MMA(0, 0, At, B0); PG8_BAR; PG8_SCHED;
            PG8_LDB(B1, 0, 1); PG8_STAGE(PG8_SB(0, 0), b2, voffB);
            PG8_BAR; PG8_WAIT_L(0); PG8_MMA(0, 1, At, B1); PG8_BAR;
            PG8_LDA(At, 0, 1); PG8_STAGE(PG8_SA(0, 0), a2, voffA);
            PG8_BAR; PG8_WAIT_L(0); PG8_MMA(1, 0, At, B0); PG8_BAR; PG8_SCHED;
            PG8_STAGE(PG8_SB(0, 1), b2 + hstep, voffB);
            PG8_WAIT_V(6); PG8_BAR; PG8_MMA(1, 1, At, B1); PG8_BAR;
            PG8_LDB(B0, 1, 0); PG8_SCHED; PG8_LDA(At, 1, 0); PG8_STAGE(PG8_SA(0, 1), a2 + hstep, voffA);
            PG8_WAIT_L(8); PG8_BAR; PG8_WAIT_L(0); PG8_MMA(0, 0, At, B0); PG8_BAR; PG8_SCHED;
            PG8_LDB(B1, 1, 1); PG8_STAGE(PG8_SB(1, 0), b3, voffB);
            PG8_BAR; PG8_WAIT_L(0); PG8_MMA(0, 1, At, B1); PG8_BAR;
            PG8_LDA(At, 1, 1); PG8_STAGE(PG8_SA(1, 0), a3, voffA);
            PG8_BAR; PG8_WAIT_L(0); PG8_MMA(1, 0, At, B0); PG8_BAR; PG8_SCHED;
            PG8_STAGE(PG8_SB(1, 1), b3 + hstep, voffB);
            PG8_WAIT_V(6); PG8_BAR; PG8_MMA(1, 1, At, B1); PG8_BAR;
            }
        }
        if constexpr (ALIGN_EPI) { if (wr == 0) PG8_BAR; }
        if constexpr (!Epi::AFTER_DRAIN) { E(acc, cur, wr, wc, fr, fq); S.done(cur); }
        if (!has_next) break;
#pragma unroll
        for (int a = 0; a < 2; ++a)
#pragma unroll
            for (int b = 0; b < 2; ++b)
#pragma unroll
                for (int m = 0; m < 4; ++m)
#pragma unroll
                    for (int n = 0; n < 2; ++n) acc[a][b][m][n] = (f32x4){0.f, 0.f, 0.f, 0.f};
        cur = nxt; cA = nA; cB = nB; ++ui;
        if constexpr (ALIGN_EPI) { if (wr == 1) PG8_BAR; }
    }
    PG8_WAIT_V(0);
    if constexpr (!ALIGN_EPI) { if (wr == 0) PG8_BAR; }
    PG8_BAR;
    if constexpr (Epi::AFTER_DRAIN) { E.fused(acc, cur, wr, wc, fr, fq, lds, wid, lane); S.done(cur); }
#undef PG8_SA
#undef PG8_SB
#undef PG8_STAGE
#undef PG8_LDA
#undef PG8_LDB
#undef PG8_MMA
#undef PG8_WAIT_V
#undef PG8_WAIT_L
#undef PG8_BAR
#undef PG8_SCHED
}
}
namespace att {
constexpr int D = 128, NW = 8, QBLK = 32, KVBLK = 64, QB = NW * QBLK, SEQ = 4096, GP = 2048  ;
constexpr int SHM_V = KVBLK * D * 2, SHM_K = KVBLK * D * 2;
constexpr int LDS_WS = 2 * SHM_V + 2 * SHM_K, LDS_BIAS = LDS_WS + NW * 64 * 4, LDS_FLAGS = LDS_BIAS + SEQ * 4, LDS_BYTES = LDS_FLAGS + 64;
typedef unsigned short bf16;
typedef short bf16x8 __attribute__((ext_vector_type(8)));
typedef short s16x4 __attribute__((ext_vector_type(4)));
typedef float f32x16 __attribute__((ext_vector_type(16)));
typedef float f32x4 __attribute__((ext_vector_type(4)));
typedef unsigned u32x4 __attribute__((ext_vector_type(4)));
typedef unsigned u32x2 __attribute__((ext_vector_type(2)));
#define KSWZ(row, colB) ((row) * 256 + ((colB) ^ (((row) & 7) << 4)))
#define SBAR() __builtin_amdgcn_sched_barrier(0)
__device__ __forceinline__ int v_st(int k, int c) { const int kk = (k & ~0xC) | ((k & 4) << 1) | ((k & 8) >> 1); return ((kk >> 3) * 4 + (c >> 5)) * 512 + ((kk & 7) * 32 + (c & 31)) * 2; }
__device__ __forceinline__ int v_rd_base(int lane) { return ((lane & 3) << 3) | (((lane >> 2) & 3) << 6) | (((lane >> 4) & 1) << 5) | (((lane >> 5) & 1) << 8); }
constexpr int v_rd_off(int d0, int ks, int half) { return d0 * 512 + ks * 4096 + half * 2048; }
__device__ __forceinline__ int crow(int r, int hi) { return (r & 3) + 8 * (r >> 2) + 4 * hi; }
__device__ __forceinline__ unsigned cvtpk(float lo, float hi) { unsigned r; asm volatile("v_cvt_pk_bf16_f32 %0, %1, %2" : "=v"(r) : "v"(lo), "v"(hi)); return r; }
__device__ __forceinline__ bf16x8 ld8(const bf16* p) { return *reinterpret_cast<const bf16x8*>(p); }
__device__ __forceinline__ float bf2f(bf16 v) { return __uint_as_float((unsigned)v << 16); }
__device__ __forceinline__ int key_of_slot(int sr) { return ((sr >> 2) & 1) * 32 + (sr & 3) + ((sr >> 3) << 2); }
__device__ __forceinline__ void mask_tile(f32x16& p0, f32x16& p1, int dq) {
    const float NEG = -__builtin_inff();
#pragma unroll
    for (int r = 0; r < 16; ++r) { if (r > dq) p0[r] = NEG; if (r + 16 > dq) p1[r] = NEG; }
}
constexpr float THR2 = 11.5f;
__device__ __forceinline__ void partialSM(f32x16& p0, f32x16& p1, float& m_reg, float& mn, float& alpha) {
    float pmax = p0[0];
#pragma unroll
    for (int r = 1; r < 16; ++r) pmax = fmaxf(pmax, p0[r]);
#pragma unroll
    for (int r = 0; r < 16; ++r) pmax = fmaxf(pmax, p1[r]);
    { auto rr = __builtin_amdgcn_permlane32_swap(__float_as_uint(pmax), __float_as_uint(pmax), false, false);
      pmax = fmaxf(__uint_as_float(rr[0]), __uint_as_float(rr[1])); }
    if (__builtin_expect(__all((pmax - m_reg) <= THR2), 1)) { mn = m_reg; alpha = 1.f; }
    else { mn = fmaxf(m_reg, pmax); alpha = __builtin_amdgcn_exp2f(m_reg - mn); m_reg = mn; }
#pragma unroll
    for (int r = 0; r < 16; ++r) p0[r] = p0[r] - mn;
#pragma unroll
    for (int r = 0; r < 16; ++r) p1[r] = p1[r] - mn;
#pragma unroll
    for (int r = 0; r < 16; ++r) p0[r] = __builtin_amdgcn_exp2f(p0[r]);
}
#define PK4(P, B_, OUT) do { unsigned a0 = cvtpk(P[B_+0], P[B_+1]), a1 = cvtpk(P[B_+2], P[B_+3]);                          \
        unsigned b0 = cvtpk(P[B_+4], P[B_+5]), b1 = cvtpk(P[B_+6], P[B_+7]);                                             \
        auto r0 = __builtin_amdgcn_permlane32_swap(a0, b0, false, false); auto r1 = __builtin_amdgcn_permlane32_swap(a1, b1, false, false); \
        u32x4 w = {r0[0], r1[0], r0[1], r1[1]}; OUT = *reinterpret_cast<bf16x8*>(&w); } while (0)
__device__ __forceinline__ void finishSM(f32x16& p0, f32x16& p1, float alpha, float& l_reg, bf16x8& pa0, bf16x8& pa1, bf16x8& pa2, bf16x8& pa3) {
#pragma unroll
    for (int r = 0; r < 16; ++r) p1[r] = __builtin_amdgcn_exp2f(p1[r]);
    float ps = 0;
#pragma unroll
    for (int r = 0; r < 16; ++r) ps += p0[r];
#pragma unroll
    for (int r = 0; r < 16; ++r) ps += p1[r];
    { auto rr = __builtin_amdgcn_permlane32_swap(__float_as_uint(ps), __float_as_uint(ps), false, false);
      ps = __uint_as_float(rr[0]) + __uint_as_float(rr[1]); }
    l_reg = l_reg * alpha + ps;
    PK4(p0, 0, pa0); PK4(p0, 8, pa1); PK4(p1, 0, pa2); PK4(p1, 8, pa3);
}
__device__ __forceinline__ void sb_math(f32x16& p0, f32x16& p1, float& R, int hi, bf16x8& pa0, bf16x8& pa1, bf16x8& pa2, bf16x8& pa3) {
    float run = 0.f;
#pragma unroll
    for (int r = 15; r >= 0; --r) { const float z = fminf(p1[r], 64.f); run -= __builtin_amdgcn_logf(1.0f + __builtin_amdgcn_exp2f(z)); p1[r] = z + run; }
#pragma unroll
    for (int r = 15; r >= 0; --r) { const float z = fminf(p0[r], 64.f); run -= __builtin_amdgcn_logf(1.0f + __builtin_amdgcn_exp2f(z)); p0[r] = z + run; }
    const auto rr = __builtin_amdgcn_permlane32_swap(__float_as_uint(run), __float_as_uint(run), false, false);
    const float partner = hi ? __uint_as_float(rr[0]) : __uint_as_float(rr[1]);
    const float base = hi ? R : R + partner;
    R = R + (run + partner);
#pragma unroll
    for (int r = 0; r < 16; ++r) p0[r] = __builtin_amdgcn_exp2f(p0[r] + base);
#pragma unroll
    for (int r = 0; r < 16; ++r) p1[r] = __builtin_amdgcn_exp2f(p1[r] + base);
    PK4(p0, 0, pa0); PK4(p0, 8, pa1); PK4(p1, 0, pa2); PK4(p1, 8, pa3);
}
template <int KB, bool BIAS>
__device__ __forceinline__ void qkt(f32x16& p0, f32x16& p1, const char* K_lds, int r32, int hi, const bf16x8* qr, const float* bias_t) {
    if constexpr (BIAS) {
#pragma unroll
        for (int i = 0; i < 4; ++i) { const f32x4 a = *(const f32x4*)(bias_t + 4 * i), b = *(const f32x4*)(bias_t + 16 + 4 * i);
            p0[4 * i] = a[0]; p0[4 * i + 1] = a[1]; p0[4 * i + 2] = a[2]; p0[4 * i + 3] = a[3]; p1[4 * i] = b[0]; p1[4 * i + 1] = b[1]; p1[4 * i + 2] = b[2]; p1[4 * i + 3] = b[3]; }
    } else { p0 = f32x16{}; p1 = f32x16{}; }
    const char* kb[4];
#pragma unroll
    for (int dd = 0; dd < 4; ++dd) kb[dd] = K_lds + KB * SHM_K + KSWZ(r32, (dd * 16 + hi * 8) * 2);
#pragma unroll
    for (int d0 = 0; d0 < 8; ++d0) { const char* a = kb[d0 & 3] + (d0 >> 2) * 128;
        bf16x8 b0 = *reinterpret_cast<const bf16x8*>(a);
        bf16x8 b1 = *reinterpret_cast<const bf16x8*>(a + 32 * 256);
        p0 = __builtin_amdgcn_mfma_f32_32x32x16_bf16(b0, qr[d0], p0, 0, 0, 0);
        p1 = __builtin_amdgcn_mfma_f32_32x32x16_bf16(b1, qr[d0], p1, 0, 0, 0); }
}
template <int VB>
__device__ __forceinline__ void pv_tile(f32x16* o, int vb0, bf16x8 pa0, bf16x8 pa1, bf16x8 pa2, bf16x8 pa3) {
#define TRRD(dst, off) asm volatile("ds_read_b64_tr_b16 %0, %1 offset:%2" : "=&v"(dst) : "v"(vb0), "i"(off) : "memory")
#define PV_D0(d0) do { s16x4 l0, l1, l2, l3, h0, h1, h2, h3; constexpr int b_ = VB * SHM_V + v_rd_off(d0, 0, 0);   \
        TRRD(l0, b_); TRRD(h0, b_ + 2048); TRRD(l1, b_ + 4096); TRRD(h1, b_ + 6144); TRRD(l2, b_ + 8192); TRRD(h2, b_ + 10240); TRRD(l3, b_ + 12288); TRRD(h3, b_ + 14336); \
        asm volatile("s_waitcnt lgkmcnt(0)" ::: "memory"); SBAR();   \
        o[d0] = __builtin_amdgcn_mfma_f32_32x32x16_bf16((bf16x8){l0[0], l0[1], l0[2], l0[3], h0[0], h0[1], h0[2], h0[3]}, pa0, o[d0], 0, 0, 0);   \
        o[d0] = __builtin_amdgcn_mfma_f32_32x32x16_bf16((bf16x8){l1[0], l1[1], l1[2], l1[3], h1[0], h1[1], h1[2], h1[3]}, pa1, o[d0], 0, 0, 0);   \
        o[d0] = __builtin_amdgcn_mfma_f32_32x32x16_bf16((bf16x8){l2[0], l2[1], l2[2], l2[3], h2[0], h2[1], h2[2], h2[3]}, pa2, o[d0], 0, 0, 0);   \
        o[d0] = __builtin_amdgcn_mfma_f32_32x32x16_bf16((bf16x8){l3[0], l3[1], l3[2], l3[3], h3[0], h3[1], h3[2], h3[3]}, pa3, o[d0], 0, 0, 0); } while (0)
    PV_D0(0); PV_D0(1); PV_D0(2); PV_D0(3);
#undef PV_D0
#undef TRRD
}
struct BlockRef { const bf16* Q; const bf16* K; const bf16* V; const bf16* Z; bf16* G; const float* cum; int P0; };
struct Seam { bf16x8 qr[8]; bf16x8 st_v0, st_v1, st_k0, st_k1; };
#define ROW(p, k0, rr) ((p) + (size_t)((k0) + (rr)) * D + sc)
#define VMW() asm volatile("s_waitcnt vmcnt(0)" ::: "memory")
#define VMWN(n) asm volatile("s_waitcnt vmcnt(%0)" :: "i"(n) : "memory")
#define SLOAD_H(Kp, Vp, k0) do { S.st_v0 = ld8(ROW(Vp, k0, asr)); S.st_v1 = ld8(ROW(Vp, k0, asr + 16));              \
                                 S.st_k0 = ld8(ROW(Kp, k0, asr)); S.st_k1 = ld8(ROW(Kp, k0, asr + 16)); } while (0)
#define SWRITE_HK(bf) do { *(bf16x8*)(K_lds + (bf) * SHM_K + kws) = S.st_k0; *(bf16x8*)(K_lds + (bf) * SHM_K + kws + 32 * 256) = S.st_k1; } while (0)
#define SWRITE_HV(bf) do { *(bf16x8*)(V_lds + (bf) * SHM_V + vst0) = S.st_v0; *(bf16x8*)(V_lds + (bf) * SHM_V + vst1) = S.st_v1; } while (0)
#define SWRITE_H(bf) do { SWRITE_HV(bf); SWRITE_HK(bf); } while (0)
#define GATED_STORE(RL) do { const float rl_ = (RL); const bf16* Zw = cur.Z + (size_t)(wid * QBLK + r32) * D + 4 * hi; bf16* Gw = cur.G + (size_t)(wid * QBLK + r32) * GP + 4 * hi;   \
    _Pragma("unroll") for (int d0 = 0; d0 < 4; ++d0) { _Pragma("unroll") for (int g_ = 0; g_ < 4; ++g_) { const u32x2 zz = *(const u32x2*)(Zw + d0 * 32 + 8 * g_);                            \
        const float v0 = o[d0][4 * g_ + 0] * rl_ * __uint_as_float(zz.x << 16), v1 = o[d0][4 * g_ + 1] * rl_ * __uint_as_float(zz.x & 0xffff0000u);                                       \
        const float v2 = o[d0][4 * g_ + 2] * rl_ * __uint_as_float(zz.y << 16), v3 = o[d0][4 * g_ + 3] * rl_ * __uint_as_float(zz.y & 0xffff0000u);                                       \
        u32x2 w_; w_.x = cvtpk(v0, v1); w_.y = cvtpk(v2, v3); *(u32x2*)(Gw + d0 * 32 + 8 * g_) = w_; } } } while (0)

__device__ __forceinline__ void fox_prime(const BlockRef& cur, char* lds, Seam& S) {
    const int tid = otid(), wid = __builtin_amdgcn_readfirstlane(tid >> 6), lane = tid & 63, r32 = lane & 31, hi = lane >> 5;
    const int sr = tid >> 4, sc = (tid & 15) * 8, asr = key_of_slot(sr), kws = KSWZ(sr, sc * 2); char* K_lds = lds + 2 * SHM_V;
#pragma unroll
    for (int d0 = 0; d0 < 8; ++d0) S.qr[d0] = ld8(cur.Q + (size_t)(wid * QBLK + r32) * D + d0 * 16 + hi * 8);
    SLOAD_H(cur.K, cur.V, 0); VMW(); SWRITE_HK(0);
    __syncthreads();
}
__device__ __forceinline__ void fox_block(const BlockRef& cur, const BlockRef& nxt, char* lds, Seam& S) {
    const int tid = otid(), wid = __builtin_amdgcn_readfirstlane(tid >> 6), lane = tid & 63, r32 = lane & 31, hi = lane >> 5;
    const int NT = (cur.P0 + QB) / KVBLK;
    const int qlo = cur.P0 + wid * QBLK, qm = qlo + r32 - 32 * hi;
    char* V_lds = lds; char* K_lds = lds + 2 * SHM_V;
    float* bias = (float*)(lds + LDS_BIAS);
    { const float cref = cur.cum[cur.P0]; SBAR();
_Pragma("unroll 1")
      for (int s = tid; s < cur.P0 + QB; s += NW * 64) bias[s] = cref - cur.cum[s];
      SBAR(); }
    __syncthreads();
    const float* bias_l = bias + hi * 32;
    float m_reg = -1e30f, l_reg = 0; f32x16 o[4] = {};
    const int sr = tid >> 4, sc = (tid & 15) * 8, asr = key_of_slot(sr), vst0 = v_st(sr, sc), vst1 = v_st(32 + sr, sc), kws = KSWZ(sr, sc * 2);
    const int vb0 = (int)(uintptr_t)V_lds + v_rd_base(lane);
    const bf16* Kh = cur.K; const bf16* Vh = cur.V;
#define RESC(a) do { if (__any((a) < 1.f)) { _Pragma("unroll") for (int d_ = 0; d_ < 4; ++d_) _Pragma("unroll") for (int r = 0; r < 16; ++r) o[d_][r] *= (a); } } while (0)
#define KBASE(t) ((t) * KVBLK)
#define MASKT(P0_, P1_, t) do { const int kb_ = KBASE(t); if (kb_ + KVBLK - 1 > qlo) mask_tile(P0_, P1_, qm - kb_); } while (0)
    constexpr int NQL = 8;
#define SEAM_K0() do { VMWN(NQL); SWRITE_HK(0); SBAR(); } while (0)
    f32x16 pA0, pA1, pB0, pB1; float mnA, mnB, alA, alB; bf16x8 pa0, pa1, pa2, pa3;
    SWRITE_HV(0); SBAR();
    if (NT > 1) SLOAD_H(Kh, Vh, KBASE(1));
    SBAR(); qkt<0, true>(pA0, pA1, K_lds, r32, hi, S.qr, bias_l + KBASE(0));
    MASKT(pA0, pA1, 0); partialSM(pA0, pA1, m_reg, mnA, alA);
    if (NT > 1) { VMW(); SWRITE_H(1); }
    __syncthreads();
#define HALF_STEP(PX0, PX1, mnX, alX, PY0, PY1, alY, t, KB, VB, SB) do {                                                      \
        SBAR(); qkt<KB, true>(PX0, PX1, K_lds, r32, hi, S.qr, bias_l + KBASE(t));                                             \
        finishSM(PY0, PY1, alY, l_reg, pa0, pa1, pa2, pa3); SBAR();                                                           \
        if ((t) + 1 < NT) { SLOAD_H(Kh, Vh, KBASE((t) + 1)); SBAR(); }                                                        \
        pv_tile<VB>(o, vb0, pa0, pa1, pa2, pa3); MASKT(PX0, PX1, (t)); partialSM(PX0, PX1, m_reg, mnX, alX);                  \
        __syncthreads();                                                                                                      \
        if ((t) + 1 < NT) { VMW(); SWRITE_H(SB); }                                                                            \
        RESC(alX); __syncthreads(); } while (0)
    for (int t = 1; t + 1 < NT; t += 2) {
        HALF_STEP(pB0, pB1, mnB, alB, pA0, pA1, alA, t, 1, 0, 0);
        HALF_STEP(pA0, pA1, mnA, alA, pB0, pB1, alB, t + 1, 0, 1, 1);
    }
    const bool even = (NT & 1) == 0;
    if (even) { SBAR(); qkt<1, true>(pB0, pB1, K_lds, r32, hi, S.qr, bias_l + KBASE(NT - 1)); SBAR(); }
    SLOAD_H(nxt.K, nxt.V, 0); SBAR();
#pragma unroll
    for (int d0 = 0; d0 < 8; ++d0) S.qr[d0] = ld8(nxt.Q + (size_t)(wid * QBLK + r32) * D + d0 * 16 + hi * 8);
    SBAR();
    finishSM(pA0, pA1, alA, l_reg, pa0, pa1, pa2, pa3); SBAR();
    pv_tile<0>(o, vb0, pa0, pa1, pa2, pa3);
    if (even) { MASKT(pB0, pB1, NT - 1); partialSM(pB0, pB1, m_reg, mnB, alB); __syncthreads(); RESC(alB);
        finishSM(pB0, pB1, alB, l_reg, pa0, pa1, pa2, pa3); SBAR(); pv_tile<1>(o, vb0, pa0, pa1, pa2, pa3); }
    SBAR(); SEAM_K0();
    GATED_STORE(__builtin_amdgcn_rcpf(l_reg));
    __syncthreads();
#undef RESC
#undef MASKT
#undef SEAM_K0
#undef HALF_STEP
}
constexpr float SB_EXIT = 128.f;
__device__ __forceinline__ void sb_block(const BlockRef& cur, char* lds) {
    const int tid = otid(), wid = __builtin_amdgcn_readfirstlane(tid >> 6), lane = tid & 63, r32 = lane & 31, hi = lane >> 5;
    const int NT = (cur.P0 + QB) / KVBLK;
    const int qlo = cur.P0 + wid * QBLK, qm = qlo + r32 - 32 * hi - 1;
    char* V_lds = lds; char* K_lds = lds + 2 * SHM_V;
    volatile unsigned* flags = (volatile unsigned*)(lds + LDS_FLAGS);
    const int sr = tid >> 4, sc = (tid & 15) * 8, asr = key_of_slot(sr), vst0 = v_st(sr, sc), vst1 = v_st(32 + sr, sc), kws = KSWZ(sr, sc * 2);
    const int vb0 = (int)(uintptr_t)V_lds + v_rd_base(lane);
    const bf16* Kh = cur.K; const bf16* Vh = cur.V;
    Seam S;
#pragma unroll
    for (int d0 = 0; d0 < 8; ++d0) S.qr[d0] = ld8(cur.Q + (size_t)(wid * QBLK + r32) * D + d0 * 16 + hi * 8);
    float R = 0.f; f32x16 o[4] = {};
    int j = NT - 1;
    SLOAD_H(Kh, Vh, j * KVBLK); VMW(); SWRITE_H(0);
    __syncthreads();
    f32x16 p0, p1; bf16x8 pa0, pa1, pa2, pa3;
#define SB_STEP(KB, NB, PAR) {                                                                                                 \
        const bool more = j > 0; const int kb_ = j * KVBLK;                                                                   \
        if (more) { SLOAD_H(Kh, Vh, kb_ - KVBLK); SBAR(); }                                                                   \
        if (kb_ <= qlo + QBLK - 2) {                                       \
            qkt<KB, false>(p0, p1, K_lds, r32, hi, S.qr, nullptr);                                                            \
            if (kb_ + KVBLK - 1 > qlo - 1) mask_tile(p0, p1, qm - kb_);                                                       \
            sb_math(p0, p1, R, hi, pa0, pa1, pa2, pa3); SBAR();                                                               \
            pv_tile<KB>(o, vb0, pa0, pa1, pa2, pa3); }                                                                        \
        const unsigned dn = __all(R < -SB_EXIT) ? 1u : 0u;                                                                    \
        if (lane == 0) flags[(PAR) * 8 + wid] = dn;                                                                           \
        if (more) { VMW(); SWRITE_H(NB); }                                                                                    \
        __syncthreads();                                                                                                      \
        unsigned alld = flags[(PAR) * 8 + (lane & 7)]; alld = __all(alld != 0u) ? 1u : 0u;                                     \
        --j; if (!more || alld) break; }
    for (;;) { SB_STEP(0, 1, 0) SB_STEP(1, 0, 1) }
#undef SB_STEP
    GATED_STORE(1.0f);
    __syncthreads();
}
#undef ROW
#undef VMW
#undef VMWN
#undef SLOAD_H
#undef SWRITE_HK
#undef SWRITE_HV
#undef SWRITE_H
#undef GATED_STORE
#undef PK4
}
constexpr int NB = 8, SEQ = 4096, DM = 1024, DI = 2048, NH = 16, DEPTH = 4, FOXC = 4 * DI + NH, SBC = 4 * DI;
constexpr int MTOT = NB * SEQ, NHALF = 2, BH = NB / NHALF, MH = BH * SEQ;
constexpr float LN_EPS = 1e-5f, ALPHA = 1.681792830507429f  , LOG2E = 1.4426950408889634f, QSCALE = 0.08838834764831845f * LOG2E;
constexpr size_t MiB = 1u << 20;
constexpr size_t WS_LOGF = 1 * MiB;
constexpr size_t WS_CUM = 3 * MiB;
constexpr size_t WS_WIN = 8 * MiB;
constexpr size_t WS_WOUT = 72 * MiB;
constexpr size_t WS_XB = 88 * MiB;
constexpr size_t WS_QKVZ = 152 * MiB;
constexpr size_t WS_G = 408 * MiB;
constexpr size_t WS_END = 472 * MiB;
constexpr int LDS_MISC = 131072, LDS_TOTAL = LDS_MISC + 1024;
static_assert(att::LDS_BYTES <= LDS_MISC && pg8::STAGE_BYTES <= LDS_MISC, "LDS map");

struct Params { const float* x; const float* fox_w_in; const float* fox_b_f; const float* fox_w_out; const float* sb_w_in; const float* sb_w_out; const float* ln_g; const float* ln_b; float* out; unsigned char* ws; };

typedef float f32x4 __attribute__((ext_vector_type(4)));
typedef unsigned u32x4 __attribute__((ext_vector_type(4)));
typedef unsigned u32x2 __attribute__((ext_vector_type(2)));
__device__ __forceinline__ float wave_sum(float v) {
#pragma unroll
    for (int o = 32; o >= 1; o >>= 1) v += __shfl_xor(v, o);
    return v;
}
__device__ __forceinline__ void transpose_tile(const float* W, int ld, int K, unsigned short* Wt, int k0, int n0, float* scr  ) {
    const int t = otid();
    { const int kk = t >> 3, nn = (t & 7) * 8; const float* src = W + (size_t)(k0 + kk) * ld + n0 + nn;
      const f32x4 a = *(const f32x4*)src, b = *(const f32x4*)(src + 4); float* d = scr + kk * 65 + nn;
      d[0] = a[0]; d[1] = a[1]; d[2] = a[2]; d[3] = a[3]; d[4] = b[0]; d[5] = b[1]; d[6] = b[2]; d[7] = b[3]; }
    __syncthreads();
    { const int nn = t >> 3, kk = (t & 7) * 8; float v[8];
#pragma unroll
      for (int j = 0; j < 8; ++j) v[j] = scr[(kk + j) * 65 + nn];
      u32x4 w; w.x = pg8::cvt_pk_bf16(v[0], v[1]); w.y = pg8::cvt_pk_bf16(v[2], v[3]); w.z = pg8::cvt_pk_bf16(v[4], v[5]); w.w = pg8::cvt_pk_bf16(v[6], v[7]);
      *(u32x4*)(Wt + (size_t)(n0 + nn) * K + k0 + kk) = w; }
    __syncthreads();
}
__device__ __forceinline__ void row_phase(const float* src, float* dstf, unsigned short* xb, float* logf2, const float* g, const float* bta, const float* wf  , const float* bf,
                                          int row_lo, int row_hi, unsigned char* lds) {
    const int tid = otid(), wid = tid >> 6, lane = tid & 63;
    float* wl = (float*)lds;
    if (wf) { for (int i = tid; i < 1024 * 4; i += 512) { const int c = i >> 2, j = i & 3; const f32x4 w = *(const f32x4*)(wf + (size_t)c * FOXC + 8192 + 4 * j);
                  wl[(4 * j + 0) * 1024 + c] = w[0]; wl[(4 * j + 1) * 1024 + c] = w[1]; wl[(4 * j + 2) * 1024 + c] = w[2]; wl[(4 * j + 3) * 1024 + c] = w[3]; }
              __syncthreads(); }
    for (int r = row_lo + obid() * 8 + wid; r < row_hi; r += ogrid() * 8) {
        f32x4 v[4];
#pragma unroll
        for (int i = 0; i < 4; ++i) v[i] = *(const f32x4*)(src + (size_t)r * DM + i * 256 + lane * 4);
        if (g) {
            float s = 0.f;
#pragma unroll
            for (int i = 0; i < 4; ++i) s += (v[i][0] + v[i][1]) + (v[i][2] + v[i][3]);
            const float mu = wave_sum(s) * (1.0f / DM); float q = 0.f;
#pragma unroll
            for (int i = 0; i < 4; ++i) { v[i] = v[i] - mu; q += (v[i][0] * v[i][0] + v[i][1] * v[i][1]) + (v[i][2] * v[i][2] + v[i][3] * v[i][3]); }
            const float rstd = 1.0f / sqrtf(wave_sum(q) * (1.0f / DM) + LN_EPS);
#pragma unroll
            for (int i = 0; i < 4; ++i) { const f32x4 gg = *(const f32x4*)(g + i * 256 + lane * 4), bb = *(const f32x4*)(bta + i * 256 + lane * 4);
                v[i] = v[i] * rstd * gg + bb; *(f32x4*)(dstf + (size_t)r * DM + i * 256 + lane * 4) = v[i]; }
        }
        if (xb) {
#pragma unroll
            for (int i = 0; i < 4; ++i) { u32x2 w; w.x = pg8::cvt_pk_bf16(v[i][0], v[i][1]); w.y = pg8::cvt_pk_bf16(v[i][2], v[i][3]); *(u32x2*)(xb + (size_t)r * DM + i * 256 + lane * 4) = w; }
        }
        if (wf) {
            float mine = 0.f;
#pragma unroll
            for (int h = 0; h < 16; ++h) { float a = 0.f;
#pragma unroll
                for (int i = 0; i < 4; ++i) { const f32x4 w = *(const f32x4*)(wl + h * 1024 + i * 256 + lane * 4); a += (v[i][0] * w[0] + v[i][1] * w[1]) + (v[i][2] * w[2] + v[i][3] * w[3]); }
                a = wave_sum(a); if (lane == h) mine = a; }
            if (lane < 16) { const float xx = mine + bf[lane]; const float ls = fminf(xx, 0.f) - log1pf(expf(-fabsf(xx))); logf2[(size_t)r * 16 + lane] = ls * LOG2E; }
        }
    }
}
__device__ __forceinline__ void cumsum_seq(const float* lf  , float* cum, float* scr  ) {
    const int tid = otid(), wid = tid >> 6, lane = tid & 63;
    float v[8]; float run = 0.f;
#pragma unroll
    for (int i = 0; i < 8; ++i) { run += lf[(size_t)(tid * 8 + i) * 16]; v[i] = run; }
    float inc = run;
#pragma unroll
    for (int o = 1; o < 64; o <<= 1) { const float t = __shfl_up(inc, o); if (lane >= o) inc += t; }
    if (lane == 63) scr[wid] = inc;
    __syncthreads();
    float off = inc - run;
    for (int w = 0; w < wid; ++w) off += scr[w];
#pragma unroll
    for (int i = 0; i < 8; ++i) cum[tid * 8 + i] = v[i] + off;
    __syncthreads();
}


#define WS_PTRS(p) unsigned char* ws = (p).ws; float* logf2 = (float*)(ws + WS_LOGF); float* cum = (float*)(ws + WS_CUM); unsigned short* win = (unsigned short*)(ws + WS_WIN); unsigned short* wout = (unsigned short*)(ws + WS_WOUT); \
    unsigned short* xb = (unsigned short*)(ws + WS_XB); unsigned short* qkvz = (unsigned short*)(ws + WS_QKVZ); unsigned short* gbuf = (unsigned short*)(ws + WS_G);       \
    (void)logf2; (void)cum; (void)win; (void)wout; (void)xb; (void)qkvz; (void)gbuf
constexpr size_t PLANE = (size_t)MH * DI;
__device__ __forceinline__ int vcu_of(int G, int bx) { return (G % 8 == 0) ? (bx % 8) * (G / 8) + bx / 8 : bx; }

__device__ __forceinline__ void ph_prologue(const Params& p, unsigned char* lds) {
    WS_PTRS(p); const int G = ogrid(), bx = obid();
    constexpr int T_IN = (DM / 64) * (8192 / 64), T_OUT = (DI / 64) * (DM / 64), T_L = T_IN + T_OUT;
    for (int t = bx; t < DEPTH * T_L; t += G) {
        const int l = t / T_L, u = t % T_L, slot = l >> 1; const bool fox = (l & 1) == 0;
        if (u < T_IN) { const float* W = fox ? p.fox_w_in + (size_t)slot * DM * FOXC : p.sb_w_in + (size_t)slot * DM * SBC;
            transpose_tile(W, fox ? FOXC : SBC, DM, win + (size_t)l * 8192 * DM, (u % (DM / 64)) * 64, (u / (DM / 64)) * 64, (float*)lds); }
        else { const int uu = u - T_IN; const float* W = (fox ? p.fox_w_out : p.sb_w_out) + (size_t)slot * DI * DM;
            transpose_tile(W, DM, DI, wout + (size_t)l * DM * DI, (uu % (DI / 64)) * 64, (uu / (DI / 64)) * 64, (float*)lds); }
    }
    row_phase(p.x, nullptr, xb, logf2, nullptr, nullptr, p.fox_w_in, p.fox_b_f, 0, MTOT, lds);
}
__device__ __forceinline__ void ph_inproj(const Params& p, int hf, int l, unsigned char* lds) {
    WS_PTRS(p); const int G = ogrid(), bx = obid(); const bool fox = (l & 1) == 0;
    if (fox && bx < BH * NH) { const int b = bx / NH, h = bx % NH;
        cumsum_seq(logf2 + ((size_t)(hf * BH + b) * SEQ) * 16 + h, cum + (size_t)bx * SEQ, (float*)(lds + LDS_MISC)); }
    pg8::Gemm g{xb + (size_t)hf * MH * DM, win + (size_t)l * 8192 * DM, MH, 8192, DM}; pg8::StaticOrder S; S.init(MH, 8192, G, bx);
    pg8::EpiQKVZ E{qkvz, PLANE, QSCALE};
    pg8::gemm_phase<pg8::EpiQKVZ, pg8::StaticOrder, true, true>((PG8_LAS unsigned char*)lds, g, S, E);
}
__device__ __forceinline__ att::BlockRef blk_ref(unsigned short* qkvz, unsigned short* gbuf, const float* cum, int bh, int qb) {
    const size_t ho = (size_t)bh * SEQ * 128, qo = ho + (size_t)qb * att::QB * 128;
    att::BlockRef r; r.Q = qkvz + qo; r.K = qkvz + PLANE + ho; r.V = qkvz + 2 * PLANE + ho; r.Z = qkvz + 3 * PLANE + qo;
    r.G = gbuf + ((size_t)(bh / NH) * SEQ + (size_t)qb * att::QB) * DI + (bh % NH) * 128; r.cum = cum + (size_t)bh * SEQ; r.P0 = qb * att::QB; return r;
}
__device__ __forceinline__ void ph_fox(const Params& p, unsigned char* lds) {
    WS_PTRS(p); const int G = ogrid(), vcu = vcu_of(G, obid());
    constexpr int NQB = SEQ / att::QB, NX = NQB / 2, TOTAL = BH * NH * NX;
    int L = vcu; if (L >= TOTAL) return;
    int pass = 0;
    att::BlockRef cur = blk_ref(qkvz, gbuf, cum, L / NX, L % NX); att::Seam S;
    att::fox_prime(cur, (char*)lds, S);
    for (;;) {
        const bool more_pass = pass == 0, more_item = L + G < TOTAL, last = !more_pass && !more_item;
        int passn = pass + 1, Ln = L; if (!more_pass) { passn = 0; Ln = more_item ? L + G : L; }
        const int xn = Ln % NX; const att::BlockRef nxt = last ? cur : blk_ref(qkvz, gbuf, cum, Ln / NX, passn ? NQB - 1 - xn : xn);
        att::fox_block(cur, nxt, (char*)lds, S);
        if (last) break;
        cur = nxt; pass = passn; L = Ln;
    }
}
__device__ __forceinline__ void ph_sb(const Params& p, unsigned char* lds) {
    WS_PTRS(p); const int G = ogrid(), vcu = vcu_of(G, obid());
    constexpr int NQB = SEQ / att::QB, TOTAL = BH * NH * NQB;
    for (int L = vcu; L < TOTAL; L += G) { const att::BlockRef r = blk_ref(qkvz, gbuf, cum, L / NQB, L % NQB); att::sb_block(r, (char*)lds); }
}
__device__ __forceinline__ void ph_outproj(const Params& p, int hf, int l, unsigned char* lds) {
    WS_PTRS(p); const int G = ogrid(), bx = obid(); const size_t ro = (size_t)hf * MH * DM;
    pg8::Gemm g{gbuf, wout + (size_t)l * DM * DI, MH, DM, DI}; pg8::StaticOrder S; S.init(MH, DM, G, bx);
    pg8::EpiRes E{(l == 0 ? p.x : p.out) + ro, p.out + ro, ALPHA};
    pg8::gemm_phase<pg8::EpiRes, pg8::StaticOrder, true, true>((PG8_LAS unsigned char*)lds, g, S, E);
}
__device__ __forceinline__ void ph_rows(const Params& p, int hf, int l, unsigned char* lds) {
    WS_PTRS(p); const bool nfox = (l + 1 < DEPTH) && (((l + 1) & 1) == 0); const int ns = (l + 1) >> 1;
    row_phase(p.out, p.out, (l + 1 < DEPTH) ? xb : nullptr, logf2, p.ln_g + l * DM, p.ln_b + l * DM,
              nfox ? p.fox_w_in + (size_t)ns * DM * FOXC : nullptr, nfox ? p.fox_b_f + ns * NH : nullptr, hf * MH, hf * MH + MH, lds);
}

#ifndef N_LAUNCH_MODE
#define N_LAUNCH_MODE 1
#endif
#if N_LAUNCH_MODE == 0
__global__ void __launch_bounds__(512, 2) k_prologue(Params p) { extern __shared__ __attribute__((aligned(16))) unsigned char lds[]; ph_prologue(p, lds); }
__global__ void __launch_bounds__(512, 2) k_inproj(Params p, int hf, int l) { extern __shared__ __attribute__((aligned(16))) unsigned char lds[]; ph_inproj(p, hf, l, lds); }
__global__ void __launch_bounds__(512, 2) k_fox(Params p) { extern __shared__ __attribute__((aligned(16))) unsigned char lds[]; ph_fox(p, lds); }
__global__ void __launch_bounds__(512, 2) k_sb(Params p) { extern __shared__ __attribute__((aligned(16))) unsigned char lds[]; ph_sb(p, lds); }
__global__ void __launch_bounds__(512, 2) k_outproj(Params p, int hf, int l) { extern __shared__ __attribute__((aligned(16))) unsigned char lds[]; ph_outproj(p, hf, l, lds); }
__global__ void __launch_bounds__(512, 2) k_rows(Params p, int hf, int l) { extern __shared__ __attribute__((aligned(16))) unsigned char lds[]; ph_rows(p, hf, l, lds); }
#else
#define PENV() const Params* pp_ = (const Params*)__builtin_amdgcn_kernarg_segment_ptr(); asm volatile("" : "+s"(pp_)); const Params& p = *pp_
__global__ void __launch_bounds__(512, 2) fox_sb_mega(Params p_unused) {
    extern __shared__ __attribute__((aligned(16))) unsigned char lds[];
    cg::grid_group grid = cg::this_grid();
    { PENV(); ph_prologue(p, lds); }
    grid.sync();
    for (int hf = 0; hf < NHALF; ++hf)
        for (int l = 0; l < DEPTH; ++l) {
            { PENV(); ph_inproj(p, hf, l, lds); }
            grid.sync();
            if ((l & 1) == 0) { PENV(); ph_fox(p, lds); } else { PENV(); ph_sb(p, lds); }
            grid.sync();
            { PENV(); ph_outproj(p, hf, l, lds); }
            grid.sync();
            { PENV(); ph_rows(p, hf, l, lds); }
            grid.sync();
        }
}
#endif

extern "C" void kernel_launch(void* const* d_in, const int* in_sizes, int n_in, void* d_out, int out_size, void* d_ws, size_t ws_size, hipStream_t stream) {
    static int grid = 0;
    if (grid == 0) {
        if (n_in != 8 || in_sizes[0] != MTOT * DM || out_size != MTOT * DM || ws_size < WS_END) { fprintf(stderr, "kernel_launch: unexpected shapes (n_in %d, in0 %d, out %d, ws %zu)\n", n_in, n_in > 0 ? in_sizes[0] : -1, out_size, ws_size); grid = -1; return; }
        int dev = 0, cus = 0;
        (void)hipGetDevice(&dev); (void)hipDeviceGetAttribute(&cus, hipDeviceAttributeMultiprocessorCount, dev);
#if N_LAUNCH_MODE == 0
        bool ok = hipFuncSetAttribute((const void*)k_prologue, hipFuncAttributeMaxDynamicSharedMemorySize, LDS_TOTAL) == hipSuccess;
        ok = ok && hipFuncSetAttribute((const void*)k_inproj, hipFuncAttributeMaxDynamicSharedMemorySize, LDS_TOTAL) == hipSuccess;
        ok = ok && hipFuncSetAttribute((const void*)k_fox, hipFuncAttributeMaxDynamicSharedMemorySize, LDS_TOTAL) == hipSuccess;
        ok = ok && hipFuncSetAttribute((const void*)k_sb, hipFuncAttributeMaxDynamicSharedMemorySize, LDS_TOTAL) == hipSuccess;
        ok = ok && hipFuncSetAttribute((const void*)k_outproj, hipFuncAttributeMaxDynamicSharedMemorySize, LDS_TOTAL) == hipSuccess;
        ok = ok && hipFuncSetAttribute((const void*)k_rows, hipFuncAttributeMaxDynamicSharedMemorySize, LDS_TOTAL) == hipSuccess;
        if (!ok) { fprintf(stderr, "kernel_launch: hipFuncSetAttribute failed\n"); grid = -1; return; }
#else
        int per_cu = 0;
        if (hipFuncSetAttribute((const void*)fox_sb_mega, hipFuncAttributeMaxDynamicSharedMemorySize, LDS_TOTAL) != hipSuccess) { fprintf(stderr, "kernel_launch: hipFuncSetAttribute failed\n"); grid = -1; return; }
        if (hipOccupancyMaxActiveBlocksPerMultiprocessor(&per_cu, (const void*)fox_sb_mega, 512, LDS_TOTAL) != hipSuccess || per_cu < 1) { fprintf(stderr, "kernel_launch: occupancy query says %d\n", per_cu); }
        (void)hipGetLastError();
#endif
        grid = cus > 0 ? cus : 256;
    }
    if (grid < 0) return;
    Params p{};
    p.x = (const float*)d_in[0]; p.fox_w_in = (const float*)d_in[1]; p.fox_b_f = (const float*)d_in[2]; p.fox_w_out = (const float*)d_in[3];
    p.sb_w_in = (const float*)d_in[4]; p.sb_w_out = (const float*)d_in[5]; p.ln_g = (const float*)d_in[6]; p.ln_b = (const float*)d_in[7];
    p.out = (float*)d_out; p.ws = (unsigned char*)d_ws;
#if N_LAUNCH_MODE == 0
    k_prologue<<<grid, 512, LDS_TOTAL, stream>>>(p);
    for (int hf = 0; hf < NHALF; ++hf)
        for (int l = 0; l < DEPTH; ++l) {
            k_inproj<<<grid, 512, LDS_TOTAL, stream>>>(p, hf, l);
            if ((l & 1) == 0) k_fox<<<grid, 512, LDS_TOTAL, stream>>>(p); else k_sb<<<grid, 512, LDS_TOTAL, stream>>>(p);
            k_outproj<<<grid, 512, LDS_TOTAL, stream>>>(p, hf, l);
            k_rows<<<grid, 512, LDS_TOTAL, stream>>>(p, hf, l);
        }
#else
    void* args[] = {&p};
    hipError_t e = hipLaunchCooperativeKernel((const void*)fox_sb_mega, dim3(grid), dim3(512), args, LDS_TOTAL, stream);
    if (e != hipSuccess) fprintf(stderr, "cooperative launch failed: %s (grid %d)\n", hipGetErrorString(e), grid);
#endif
}
```

```cpp
#include <hip/hip_runtime.h>
#include <hip/hip_cooperative_groups.h>
#include <cstdio>
#include <cstdint>
namespace cg = cooperative_groups;
__device__ __forceinline__ int otid() { int t = threadIdx.x; asm volatile("" : "+v"(t)); return t; }
__device__ __forceinline__ int obid() { int t = blockIdx.x; asm volatile("" : "+s"(t)); return t; }
__device__ __forceinline__ int ogrid() { int t = gridDim.x; asm volatile("" : "+s"(t)); return t; }
namespace pg8 {
#define PG8_LAS __attribute__((address_space(3)))
typedef unsigned short bf16_t;
typedef short bf16x8 __attribute__((ext_vector_type(8)));
typedef float f32x4 __attribute__((ext_vector_type(4)));
typedef unsigned u32x4 __attribute__((ext_vector_type(4)));
constexpr int BM = 256, BK = 64, HALF = 128, HTB = HALF * BK * 2  , STAGE_BYTES = 8 * HTB, NXCD = 8, WGM = 8;

__host__ __device__ __forceinline__ int lds_byte(int r, int c) { const int st = (r >> 4) * 2 + (c >> 5), rr = r & 15, cc = c & 31, ob = rr * 64 + cc * 2; return st * 1024 + (ob ^ (((ob >> 9) & 1) << 5)); }
__host__ __device__ __forceinline__ void stage_rc(int b, int& R, int& C) { const int st = b / 1024, sb = b % 1024, swz = sb ^ (((sb >> 9) & 1) << 5); R = (st >> 1) * 16 + swz / 64; C = (st & 1) * 32 + (swz % 64) / 2; }
__host__ __device__ __forceinline__ int perm32(int rho) { const int n = rho >> 4, i = rho & 15; return 8 * (i >> 2) + 4 * n + (i & 3); }

struct Unit { int pm, pn; };
struct Gemm { const bf16_t* A; const bf16_t* Bt; int M, N, K; };

struct StaticOrder {
    int nM, nN, nwg, G, c;
    __host__ __device__ void init(int M, int N, int G_, int c_) { nM = M / BM; nN = N / BM; nwg = nM * nN; G = G_; c = c_; }
    __host__ __device__ bool next(int i, Unit& u) const {
        const long L = (long)i * G + c; if (L >= nwg) return false;
        int wgid = (int)L; { const int q = nwg / NXCD, r = nwg % NXCD, xcd = wgid % NXCD, off = wgid / NXCD; wgid = (xcd < r ? xcd * (q + 1) : r * (q + 1) + (xcd - r) * q) + off; }
        const int nig = WGM * nN, gid = wgid / nig, fm = gid * WGM, gsz = (nM - fm) < WGM ? (nM - fm) : WGM;
        u.pm = fm + ((wgid % nig) % gsz); u.pn = (wgid % nig) / gsz; return true;
    }
    __device__ __forceinline__ void a_ready(const Unit&) const {}
    __device__ __forceinline__ void done(const Unit&) const {}
};

__device__ __forceinline__ unsigned cvt_pk_bf16(float lo, float hi) { unsigned r; asm volatile("v_cvt_pk_bf16_f32 %0, %1, %2" : "=v"(r) : "v"(lo), "v"(hi)); return r; }
struct EpiQKVZ {
    static constexpr bool PERM = true, AFTER_DRAIN = false;
    bf16_t* O; size_t wstride; float qscale;
    __device__ __forceinline__ void operator()(const f32x4 (&acc)[2][2][4][2], const Unit& u, int wr, int wc, int fr, int fq) const {
        const int row0 = u.pm * BM + wr * 64 + fr; const int colt = u.pn * BM; const int which = colt >> 11; const int head0 = (colt & 2047) >> 7;
        const int d0 = wc * 32 + 8 * fq; bf16_t* base = O + (size_t)which * wstride;
#pragma unroll
        for (int ai = 0; ai < 2; ++ai)
#pragma unroll
            for (int m = 0; m < 4; ++m) { const int r = row0 + ai * HALF + m * 16; const int b = r >> 12, s = r & 4095;
#pragma unroll
                for (int bj = 0; bj < 2; ++bj) { bf16_t* ptr = base + ((size_t)((b * 16 + head0 + bj) * 4096 + s)) * 128 + d0;
                    f32x4 v0 = acc[ai][bj][m][0], v1 = acc[ai][bj][m][1];
                    if (which == 0) { v0 = v0 * qscale; v1 = v1 * qscale; }
                    if (which == 3) {
#pragma unroll
                        for (int j = 0; j < 4; ++j) { v0[j] = v0[j] * __builtin_amdgcn_rcpf(1.0f + __builtin_amdgcn_exp2f(-1.4426950408889634f * v0[j]));
                                                      v1[j] = v1[j] * __builtin_amdgcn_rcpf(1.0f + __builtin_amdgcn_exp2f(-1.4426950408889634f * v1[j])); } }
                    u32x4 w; w.x = cvt_pk_bf16(v0[0], v0[1]); w.y = cvt_pk_bf16(v0[2], v0[3]); w.z = cvt_pk_bf16(v1[0], v1[1]); w.w = cvt_pk_bf16(v1[2], v1[3]);
                    *(u32x4*)ptr = w; } }
    }
};
struct EpiRes {
    static constexpr bool PERM = false, AFTER_DRAIN = false;
    const float* xres; float* out; float alpha;
    __device__ __forceinline__ void operator()(const f32x4 (&acc)[2][2][4][2], const Unit& u, int wr, int wc, int fr, int fq) const {
        const int row0 = u.pm * BM + wr * 64 + fr; const int col0 = u.pn * BM + wc * 32 + 4 * fq;
#pragma unroll
        for (int ai = 0; ai < 2; ++ai)
#pragma unroll
            for (int m = 0; m < 4; ++m) { const size_t ro = (size_t)(row0 + ai * HALF + m * 16) * 1024;
#pragma unroll
                for (int bj = 0; bj < 2; ++bj)
#pragma unroll
                    for (int n = 0; n < 2; ++n) { const size_t o = ro + col0 + bj * HALF + 16 * n;
                        const f32x4 xr = *(const f32x4*)(xres + o); *(f32x4*)(out + o) = xr * alpha + acc[ai][bj][m][n]; } }
    }
};

template <class Epi, class Sched, bool ALIGN_EPI = false, bool SP2 = false>
__device__ __forceinline__ void gemm_phase(PG8_LAS unsigned char* lds, const Gemm g, const Sched& S, const Epi& E) {
    const int tid = otid(), wid = __builtin_amdgcn_readfirstlane(tid >> 6), lane = tid & 63, wr = wid >> 2, wc = wid & 3, fr = lane & 15, fq = lane >> 4;
    const int K = g.K, nt = K / BK;
    unsigned voffA[2], voffB[2];
#pragma unroll
    for (int i = 0; i < 2; ++i) { int R, C; stage_rc(tid * 16 + i * 8192, R, C); const int Rb = Epi::PERM ? ((R & ~31) + perm32(R & 31)) : R;
        voffA[i] = (unsigned)(R * K + C) * 2u; voffB[i] = (unsigned)(Rb * K + C) * 2u; }
    const size_t kstep = (size_t)(BK * 2);
    const size_t hstep = (size_t)HALF * K * 2;
    const size_t tstep = 2 * hstep;
    const unsigned ldsw = (unsigned)wid * 1024u;
    const int aoff = lds_byte(wr * 64 + fr, fq * 8), boff = lds_byte(wc * 32 + fr, fq * 8);
#define PG8_SA(b, h) (((b) * 2 + (h)) * HTB)
#define PG8_SB(b, h) ((4 + (b) * 2 + (h)) * HTB)
#define PG8_STAGE(bufoff, gbase, voff) do { _Pragma("unroll") for (int _i = 0; _i < 2; ++_i) \
        __builtin_amdgcn_global_load_lds((const unsigned*)((const char*)(gbase) + (voff)[_i]), (PG8_LAS unsigned*)(lds + (bufoff) + ldsw + _i * 8192), 16, 0, 0); } while (0)
#define PG8_LDA(dst, b, h) do { _Pragma("unroll") for (int m = 0; m < 4; ++m) _Pragma("unroll") for (int k = 0; k < 2; ++k) dst[m][k] = *(const PG8_LAS bf16x8*)(lds + PG8_SA(b, h) + aoff + m * 2048 + k * 1024); } while (0)
#define PG8_LDB(dst, b, h) do { _Pragma("unroll") for (int n = 0; n < 2; ++n) _Pragma("unroll") for (int k = 0; k < 2; ++k) dst[n][k] = *(const PG8_LAS bf16x8*)(lds + PG8_SB(b, h) + boff + n * 2048 + k * 1024); } while (0)
#define PG8_MMA(ai, bj, At, Bt) do { __builtin_amdgcn_s_setprio(1); _Pragma("unroll") for (int m = 0; m < 4; ++m) _Pragma("unroll") for (int n = 0; n < 2; ++n) _Pragma("unroll") for (int k = 0; k < 2; ++k) \
        acc[ai][bj][m][n] = __builtin_amdgcn_mfma_f32_16x16x32_bf16(Bt[n][k], At[m][k], acc[ai][bj][m][n], 0, 0, 0); __builtin_amdgcn_s_setprio(0); } while (0)
#define PG8_WAIT_V(n) asm volatile("s_waitcnt vmcnt(" #n ")" ::: "memory")
#define PG8_WAIT_L(n) asm volatile("s_waitcnt lgkmcnt(" #n ")" ::: "memory")
#define PG8_BAR __builtin_amdgcn_s_barrier()
#define PG8_SCHED __builtin_amdgcn_sched_barrier(0)
    Unit cur, nxt; int ui = 0;
    if (!S.next(0, cur)) return;
    f32x4 acc[2][2][4][2];
#pragma unroll
    for (int a = 0; a < 2; ++a)
#pragma unroll
        for (int b = 0; b < 2; ++b)
#pragma unroll
            for (int m = 0; m < 4; ++m)
#pragma unroll
                for (int n = 0; n < 2; ++n) acc[a][b][m][n] = (f32x4){0.f, 0.f, 0.f, 0.f};
    bf16x8 At[4][2], B0[2][2], B1[2][2];
    const char* cA = (const char*)g.A + (size_t)cur.pm * tstep; const char* cB = (const char*)g.Bt + (size_t)cur.pn * tstep;
    S.a_ready(cur);
    if constexpr (SP2) {
        PG8_STAGE(PG8_SB(0, 0), cB, voffB); PG8_STAGE(PG8_SB(0, 1), cB + hstep, voffB); PG8_STAGE(PG8_SA(0, 0), cA, voffA); PG8_STAGE(PG8_SA(0, 1), cA + hstep, voffA);
        if (wr == 1) PG8_BAR;
        PG8_WAIT_V(2); PG8_BAR;
        PG8_STAGE(PG8_SB(1, 0), cB + kstep, voffB); PG8_STAGE(PG8_SA(1, 0), cA + kstep, voffA); PG8_STAGE(PG8_SB(1, 1), cB + hstep + kstep, voffB);
        PG8_WAIT_V(6); PG8_BAR;
    } else {
        PG8_STAGE(PG8_SB(0, 0), cB, voffB); PG8_STAGE(PG8_SA(0, 0), cA, voffA); PG8_STAGE(PG8_SB(0, 1), cB + hstep, voffB); PG8_STAGE(PG8_SA(0, 1), cA + hstep, voffA);
        if (wr == 1) PG8_BAR;
        PG8_WAIT_V(4); PG8_BAR;
        PG8_STAGE(PG8_SB(1, 0), cB + kstep, voffB); PG8_STAGE(PG8_SA(1, 0), cA + kstep, voffA); PG8_STAGE(PG8_SB(1, 1), cB + hstep + kstep, voffB);
        PG8_WAIT_V(6); PG8_BAR;
    }
    for (;;) {
        const bool has_next = S.next(ui + 1, nxt);
        const char* nA = has_next ? (const char*)g.A + (size_t)nxt.pm * tstep : cA; const char* nB = has_next ? (const char*)g.Bt + (size_t)nxt.pn * tstep : cB;
        for (int t = 0; t < nt; t += 2) {
            const bool last = (t == nt - 2);
            const char* a1 = cA + (size_t)(t + 1) * kstep;
            const char* a2 = last ? nA : cA + (size_t)(t + 2) * kstep; const char* b2 = last ? nB : cB + (size_t)(t + 2) * kstep;
            const char* a3 = a2 + kstep; const char* b3 = b2 + kstep;
            if (last && has_next) S.a_ready(nxt);
            if constexpr (SP2) {
            PG8_LDB(B0, 0, 0); PG8_LDB(B1, 0, 1); PG8_SCHED; PG8_LDA(At, 0, 0); PG8_STAGE(PG8_SA(1, 1), a1 + hstep, voffA);
            PG8_WAIT_V(8); PG8_WAIT_L(0); PG8_BAR; PG8_MMA(0, 0, At, B0); PG8_MMA(0, 1, At, B1); PG8_BAR; PG8_SCHED;
            PG8_LDA(At, 0, 1); PG8_STAGE(PG8_SB(0, 0), b2, voffB); PG8_STAGE(PG8_SB(0, 1), b2 + hstep, voffB); PG8_STAGE(PG8_SA(0, 0), a2, voffA);
            PG8_WAIT_V(8); PG8_WAIT_L(0); PG8_BAR; PG8_MMA(1, 0, At, B0); PG8_MMA(1, 1, At, B1); PG8_BAR; PG8_SCHED;
            PG8_LDB(B0, 1, 0); PG8_LDB(B1, 1, 1); PG8_SCHED; PG8_LDA(At, 1, 0); PG8_STAGE(PG8_SA(0, 1), a2 + hstep, voffA);
            PG8_WAIT_V(8); PG8_WAIT_L(0); PG8_BAR; PG8_MMA(0, 0, At, B0); PG8_MMA(0, 1, At, B1); PG8_BAR; PG8_SCHED;
            PG8_LDA(At, 1, 1); PG8_STAGE(PG8_SB(1, 0), b3, voffB); PG8_STAGE(PG8_SB(1, 1), b3 + hstep, voffB); PG8_STAGE(PG8_SA(1, 0), a3, voffA);
            PG8_WAIT_V(8); PG8_WAIT_L(0); PG8_BAR; PG8_MMA(1, 0, At, B0); PG8_MMA(1, 1, At, B1); PG8_BAR; PG8_SCHED;
            } else {
            PG8_LDB(B0, 0, 0); PG8_SCHED; PG8_LDA(At, 0, 0); PG8_STAGE(PG8_SA(1, 1), a1 + hstep, voffA);
            PG8_WAIT_L(8); PG8_BAR; PG8_WAIT_L(0); PG8_MMA(0, 0, At, B0); PG8_BAR; PG8_SCHED;
            PG8_LDB(B1, 0, 1); PG8_STAGE(PG8_SB(0, 0), b2, voffB);
            PG8_BAR; PG8_WAIT_L(0); PG8_MMA(0, 1, At, B1); PG8_BAR;
            PG8_LDA(At, 0, 1); PG8_STAGE(PG8_SA(0, 0), a2, voffA);
            PG8_BAR; PG8_WAIT_L(0); PG8_MMA(1, 0, At, B0); PG8_BAR; PG8_SCHED;
            PG8_STAGE(PG8_SB(0, 1), b2 + hstep, voffB);
            PG8_WAIT_V(6); PG8_BAR; PG8_MMA(1, 1, At, B1); PG8_BAR;
            PG8_LDB(B0, 1, 0); PG8_SCHED; PG8_LDA(At, 1, 0); PG8_STAGE(PG8_SA(0, 1), a2 + hstep, voffA);
            PG8_WAIT_L(8); PG8_BAR; PG8_WAIT_L(0); PG8_MMA(0, 0, At, B0); PG8_BAR; PG8_SCHED;
            PG8_LDB(B1, 1, 1); PG8_STAGE(PG8_SB(1, 0), b3, voffB);
            PG8_BAR; PG8_WAIT_L(0); PG8_MMA(0, 1, At, B1); PG8_BAR;
            PG8_LDA(At, 1, 1); PG8_STAGE(PG8_SA(1, 0), a3, voffA);
            PG8_BAR; PG8_WAIT_L(0); PG8_MMA(1, 0, At, B0); PG8_BAR; PG8_SCHED;
            PG8_STAGE(PG8_SB(1, 1), b3 + hstep, voffB);
            PG8_WAIT_V(6); PG8_BAR; PG8_MMA(1, 1, At, B1); PG8_BAR;
            }
        }
        if constexpr (ALIGN_EPI) { if (wr == 0) PG8_BAR; }
        if constexpr (!Epi::AFTER_DRAIN) { E(acc, cur, wr, wc, fr, fq); S.done(cur); }
        if (!has_next) break;
#pragma unroll
        for (int a = 0; a < 2; ++a)
#pragma unroll
            for (int b = 0; b < 2; ++b)
#pragma unroll
                for (int m = 0; m < 4; ++m)
#pragma unroll
                    for (int n = 0; n < 2; ++n) acc[a][b][m][n] = (f32x4){0.f, 0.f, 0.f, 0.f};
        cur = nxt; cA = nA; cB = nB; ++ui;
        if constexpr (ALIGN_EPI) { if (wr == 1) PG8_BAR; }
    }
    PG8_WAIT_V(0);
    if constexpr (!ALIGN_EPI) { if (wr == 0) PG8_BAR; }
    PG8_BAR;
    if constexpr (Epi::AFTER_DRAIN) { E.fused(acc, cur, wr, wc, fr, fq, lds, wid, lane); S.done(cur); }
#undef PG8_SA
#undef PG8_SB
#undef PG8_STAGE
#undef PG8_LDA
#undef PG8_LDB
#undef PG8_MMA
#undef PG8_WAIT_V
#undef PG8_WAIT_L
#undef PG8_BAR
#undef PG8_SCHED
}
}
namespace att {
constexpr int D = 128, NW = 8, QBLK = 32, KVBLK = 64, QB = NW * QBLK, SEQ = 4096, GP = 2048  ;
constexpr int SHM_V = KVBLK * D * 2, SHM_K = KVBLK * D * 2;
constexpr int LDS_WS = 2 * SHM_V + 2 * SHM_K, LDS_BIAS = LDS_WS + NW * 64 * 4, LDS_FLAGS = LDS_BIAS + SEQ * 4, LDS_BYTES = LDS_FLAGS + 64;
typedef unsigned short bf16;
typedef short bf16x8 __attribute__((ext_vector_type(8)));
typedef short s16x4 __attribute__((ext_vector_type(4)));
typedef float f32x16 __attribute__((ext_vector_type(16)));
typedef float f32x4 __attribute__((ext_vector_type(4)));
typedef unsigned u32x4 __attribute__((ext_vector_type(4)));
typedef unsigned u32x2 __attribute__((ext_vector_type(2)));
#define KSWZ(row, colB) ((row) * 256 + ((colB) ^ (((row) & 7) << 4)))
#define SBAR() __builtin_amdgcn_sched_barrier(0)
__device__ __forceinline__ int v_st(int k, int c) { const int kk = (k & ~0xC) | ((k & 4) << 1) | ((k & 8) >> 1); return ((kk >> 3) * 4 + (c >> 5)) * 512 + ((kk & 7) * 32 + (c & 31)) * 2; }
__device__ __forceinline__ int v_rd_base(int lane) { return ((lane & 3) << 3) | (((lane >> 2) & 3) << 6) | (((lane >> 4) & 1) << 5) | (((lane >> 5) & 1) << 8); }
constexpr int v_rd_off(int d0, int ks, int half) { return d0 * 512 + ks * 4096 + half * 2048; }
__device__ __forceinline__ int crow(int r, int hi) { return (r & 3) + 8 * (r >> 2) + 4 * hi; }
__device__ __forceinline__ unsigned cvtpk(float lo, float hi) { unsigned r; asm volatile("v_cvt_pk_bf16_f32 %0, %1, %2" : "=v"(r) : "v"(lo), "v"(hi)); return r; }
__device__ __forceinline__ bf16x8 ld8(const bf16* p) { return *reinterpret_cast<const bf16x8*>(p); }
__device__ __forceinline__ float bf2f(bf16 v) { return __uint_as_float((unsigned)v << 16); }
__device__ __forceinline__ int key_of_slot(int sr) { return ((sr >> 2) & 1) * 32 + (sr & 3) + ((sr >> 3) << 2); }
__device__ __forceinline__ void mask_tile(f32x16& p0, f32x16& p1, int dq) {
    const float NEG = -__builtin_inff();
#pragma unroll
    for (int r = 0; r < 16; ++r) { if (r > dq) p0[r] = NEG; if (r + 16 > dq) p1[r] = NEG; }
}
constexpr float THR2 = 11.5f;
__device__ __forceinline__ void partialSM(f32x16& p0, f32x16& p1, float& m_reg, float& mn, float& alpha) {
    float pmax = p0[0];
#pragma unroll
    for (int r = 1; r < 16; ++r) pmax = fmaxf(pmax, p0[r]);
#pragma unroll
    for (int r = 0; r < 16; ++r) pmax = fmaxf(pmax, p1[r]);
    { auto rr = __builtin_amdgcn_permlane32_swap(__float_as_uint(pmax), __float_as_uint(pmax), false, false);
      pmax = fmaxf(__uint_as_float(rr[0]), __uint_as_float(rr[1])); }
    if (__builtin_expect(__all((pmax - m_reg) <= THR2), 1)) { mn = m_reg; alpha = 1.f; }
    else { mn = fmaxf(m_reg, pmax); alpha = __builtin_amdgcn_exp2f(m_reg - mn); m_reg = mn; }
#pragma unroll
    for (int r = 0; r < 16; ++r) p0[r] = p0[r] - mn;
#pragma unroll
    for (int r = 0; r < 16; ++r) p1[r] = p1[r] - mn;
#pragma unroll
    for (int r = 0; r < 16; ++r) p0[r] = __builtin_amdgcn_exp2f(p0[r]);
}
#define PK4(P, B_, OUT) do { unsigned a0 = cvtpk(P[B_+0], P[B_+1]), a1 = cvtpk(P[B_+2], P[B_+3]);                          \
        unsigned b0 = cvtpk(P[B_+4], P[B_+5]), b1 = cvtpk(P[B_+6], P[B_+7]);                                             \
        auto r0 = __builtin_amdgcn_permlane32_swap(a0, b0, false, false); auto r1 = __builtin_amdgcn_permlane32_swap(a1, b1, false, false); \
        u32x4 w = {r0[0], r1[0], r0[1], r1[1]}; OUT = *reinterpret_cast<bf16x8*>(&w); } while (0)
__device__ __forceinline__ void finishSM(f32x16& p0, f32x16& p1, float alpha, float& l_reg, bf16x8& pa0, bf16x8& pa1, bf16x8& pa2, bf16x8& pa3) {
#pragma unroll
    for (int r = 0; r < 16; ++r) p1[r] = __builtin_amdgcn_exp2f(p1[r]);
    float ps = 0;
#pragma unroll
    for (int r = 0; r < 16; ++r) ps += p0[r];
#pragma unroll
    for (int r = 0; r < 16; ++r) ps += p1[r];
    { auto rr = __builtin_amdgcn_permlane32_swap(__float_as_uint(ps), __float_as_uint(ps), false, false);
      ps = __uint_as_float(rr[0]) + __uint_as_float(rr[1]); }
    l_reg = l_reg * alpha + ps;
    PK4(p0, 0, pa0); PK4(p0, 8, pa1); PK4(p1, 0, pa2); PK4(p1, 8, pa3);
}
__device__ __forceinline__ void sb_math(f32x16& p0, f32x16& p1, float& R, int hi, bf16x8& pa0, bf16x8& pa1, bf16x8& pa2, bf16x8& pa3) {
    float run = 0.f;
#pragma unroll
    for (int r = 15; r >= 0; --r) { const float z = fminf(p1[r], 64.f); run -= __builtin_amdgcn_logf(1.0f + __builtin_amdgcn_exp2f(z)); p1[r] = z + run; }
#pragma unroll
    for (int r = 15; r >= 0; --r) { const float z = fminf(p0[r], 64.f); run -= __builtin_amdgcn_logf(1.0f + __builtin_amdgcn_exp2f(z)); p0[r] = z + run; }
    const auto rr = __builtin_amdgcn_permlane32_swap(__float_as_uint(run), __float_as_uint(run), false, false);
    const float partner = hi ? __uint_as_float(rr[0]) : __uint_as_float(rr[1]);
    const float base = hi ? R : R + partner;
    R = R + (run + partner);
#pragma unroll
    for (int r = 0; r < 16; ++r) p0[r] = __builtin_amdgcn_exp2f(p0[r] + base);
#pragma unroll
    for (int r = 0; r < 16; ++r) p1[r] = __builtin_amdgcn_exp2f(p1[r] + base);
    PK4(p0, 0, pa0); PK4(p0, 8, pa1); PK4(p1, 0, pa2); PK4(p1, 8, pa3);
}
template <int KB, bool BIAS>
__device__ __forceinline__ void qkt(f32x16& p0, f32x16& p1, const char* K_lds, int r32, int hi, const bf16x8* qr, const float* bias_t) {
    if constexpr (BIAS) {
#pragma unroll
        for (int i = 0; i < 4; ++i) { const f32x4 a = *(const f32x4*)(bias_t + 4 * i), b = *(const f32x4*)(bias_t + 16 + 4 * i);
            p0[4 * i] = a[0]; p0[4 * i + 1] = a[1]; p0[4 * i + 2] = a[2]; p0[4 * i + 3] = a[3]; p1[4 * i] = b[0]; p1[4 * i + 1] = b[1]; p1[4 * i + 2] = b[2]; p1[4 * i + 3] = b[3]; }
    } else { p0 = f32x16{}; p1 = f32x16{}; }
    const char* kb[4];
#pragma unroll
    for (int dd = 0; dd < 4; ++dd) kb[dd] = K_lds + KB * SHM_K + KSWZ(r32, (dd * 16 + hi * 8) * 2);
#pragma unroll
    for (int d0 = 0; d0 < 8; ++d0) { const char* a = kb[d0 & 3] + (d0 >> 2) * 128;
        bf16x8 b0 = *reinterpret_cast<const bf16x8*>(a);
        bf16x8 b1 = *reinterpret_cast<const bf16x8*>(a + 32 * 256);
        p0 = __builtin_amdgcn_mfma_f32_32x32x16_bf16(b0, qr[d0], p0, 0, 0, 0);
        p1 = __builtin_amdgcn_mfma_f32_32x32x16_bf16(b1, qr[d0], p1, 0, 0, 0); }
}
template <int VB>
__device__ __forceinline__ void pv_tile(f32x16* o, int vb0, bf16x8 pa0, bf16x8 pa1, bf16x8 pa2, bf16x8 pa3) {
#define TRRD(dst, off) asm volatile("ds_read_b64_tr_b16 %0, %1 offset:%2" : "=&v"(dst) : "v"(vb0), "i"(off) : "memory")
#define PV_D0(d0) do { s16x4 l0, l1, l2, l3, h0, h1, h2, h3; constexpr int b_ = VB * SHM_V + v_rd_off(d0, 0, 0);   \
        TRRD(l0, b_); TRRD(h0, b_ + 2048); TRRD(l1, b_ + 4096); TRRD(h1, b_ + 6144); TRRD(l2, b_ + 8192); TRRD(h2, b_ + 10240); TRRD(l3, b_ + 12288); TRRD(h3, b_ + 14336); \
        asm volatile("s_waitcnt lgkmcnt(0)" ::: "memory"); SBAR();   \
        o[d0] = __builtin_amdgcn_mfma_f32_32x32x16_bf16((bf16x8){l0[0], l0[1], l0[2], l0[3], h0[0], h0[1], h0[2], h0[3]}, pa0, o[d0], 0, 0, 0);   \
        o[d0] = __builtin_amdgcn_mfma_f32_32x32x16_bf16((bf16x8){l1[0], l1[1], l1[2], l1[3], h1[0], h1[1], h1[2], h1[3]}, pa1, o[d0], 0, 0, 0);   \
        o[d0] = __builtin_amdgcn_mfma_f32_32x32x16_bf16((bf16x8){l2[0], l2[1], l2[2], l2[3], h2[0], h2[1], h2[2], h2[3]}, pa2, o[d0], 0, 0, 0);   \
        o[d0] = __builtin_amdgcn_mfma_f32_32x32x16_bf16((bf16x8){l3[0], l3[1], l3[2], l3[3], h3[0], h3[1], h3[2], h3[3]}, pa3, o[d0], 0, 0, 0); } while (0)
    PV_D0(0); PV_D0(1); PV_D0(2); PV_D0(3);
#undef PV_D0
#undef TRRD
}
struct BlockRef { const bf16* Q; const bf16* K; const bf16* V; const bf16* Z; bf16* G; const float* cum; int P0; };
struct Seam { bf16x8 qr[8]; bf16x8 st_v0, st_v1, st_k0, st_k1; };
#define ROW(p, k0, rr) ((p) + (size_t)((k0) + (rr)) * D + sc)
#define VMW() asm volatile("s_waitcnt vmcnt(0)" ::: "memory")
#define VMWN(n) asm volatile("s_waitcnt vmcnt(%0)" :: "i"(n) : "memory")
#define SLOAD_H(Kp, Vp, k0) do { S.st_v0 = ld8(ROW(Vp, k0, asr)); S.st_v1 = ld8(ROW(Vp, k0, asr + 16));              \
                                 S.st_k0 = ld8(ROW(Kp, k0, asr)); S.st_k1 = ld8(ROW(Kp, k0, asr + 16)); } while (0)
#define SWRITE_HK(bf) do { *(bf16x8*)(K_lds + (bf) * SHM_K + kws) = S.st_k0; *(bf16x8*)(K_lds + (bf) * SHM_K + kws + 32 * 256) = S.st_k1; } while (0)
#define SWRITE_HV(bf) do { *(bf16x8*)(V_lds + (bf) * SHM_V + vst0) = S.st_v0; *(bf16x8*)(V_lds + (bf) * SHM_V + vst1) = S.st_v1; } while (0)
#define SWRITE_H(bf) do { SWRITE_HV(bf); SWRITE_HK(bf); } while (0)
#define GATED_STORE(RL) do { const float rl_ = (RL); const bf16* Zw = cur.Z + (size_t)(wid * QBLK + r32) * D + 4 * hi; bf16* Gw = cur.G + (size_t)(wid * QBLK + r32) * GP + 4 * hi;   \
    _Pragma("unroll") for (int d0 = 0; d0 < 4; ++d0) { _Pragma("unroll") for (int g_ = 0; g_ < 4; ++g_) { const u32x2 zz = *(const u32x2*)(Zw + d0 * 32 + 8 * g_);                            \
        const float v0 = o[d0][4 * g_ + 0] * rl_ * __uint_as_float(zz.x << 16), v1 = o[d0][4 * g_ + 1] * rl_ * __uint_as_float(zz.x & 0xffff0000u);                                       \
        const float v2 = o[d0][4 * g_ + 2] * rl_ * __uint_as_float(zz.y << 16), v3 = o[d0][4 * g_ + 3] * rl_ * __uint_as_float(zz.y & 0xffff0000u);                                       \
        u32x2 w_; w_.x = cvtpk(v0, v1); w_.y = cvtpk(v2, v3); *(u32x2*)(Gw + d0 * 32 + 8 * g_) = w_; } } } while (0)

__device__ __forceinline__ void fox_prime(const BlockRef& cur, char* lds, Seam& S) {
    const int tid = otid(), wid = __builtin_amdgcn_readfirstlane(tid >> 6), lane = tid & 63, r32 = lane & 31, hi = lane >> 5;
    const int sr = tid >> 4, sc = (tid & 15) * 8, asr = key_of_slot(sr), kws = KSWZ(sr, sc * 2); char* K_lds = lds + 2 * SHM_V;
#pragma unroll
    for (int d0 = 0; d0 < 8; ++d0) S.qr[d0] = ld8(cur.Q + (size_t)(wid * QBLK + r32) * D + d0 * 16 + hi * 8);
    SLOAD_H(cur.K, cur.V, 0); VMW(); SWRITE_HK(0);
    __syncthreads();
}
__device__ __forceinline__ void fox_block(const BlockRef& cur, const BlockRef& nxt, char* lds, Seam& S) {
    const int tid = otid(), wid = __builtin_amdgcn_readfirstlane(tid >> 6), lane = tid & 63, r32 = lane & 31, hi = lane >> 5;
    const int NT = (cur.P0 + QB) / KVBLK;
    const int qlo = cur.P0 + wid * QBLK, qm = qlo + r32 - 32 * hi;
    char* V_lds = lds; char* K_lds = lds + 2 * SHM_V;
    float* bias = (float*)(lds + LDS_BIAS);
    { const float cref = cur.cum[cur.P0]; SBAR();
_Pragma("unroll 1")
      for (int s = tid; s < cur.P0 + QB; s += NW * 64) bias[s] = cref - cur.cum[s];
      SBAR(); }
    __syncthreads();
    const float* bias_l = bias + hi * 32;
    float m_reg = -1e30f, l_reg = 0; f32x16 o[4] = {};
    const int sr = tid >> 4, sc = (tid & 15) * 8, asr = key_of_slot(sr), vst0 = v_st(sr, sc), vst1 = v_st(32 + sr, sc), kws = KSWZ(sr, sc * 2);
    const int vb0 = (int)(uintptr_t)V_lds + v_rd_base(lane);
    const bf16* Kh = cur.K; const bf16* Vh = cur.V;
#define RESC(a) do { if (__any((a) < 1.f)) { _Pragma("unroll") for (int d_ = 0; d_ < 4; ++d_) _Pragma("unroll") for (int r = 0; r < 16; ++r) o[d_][r] *= (a); } } while (0)
#define KBASE(t) ((t) * KVBLK)
#define MASKT(P0_, P1_, t) do { const int kb_ = KBASE(t); if (kb_ + KVBLK - 1 > qlo) mask_tile(P0_, P1_, qm - kb_); } while (0)
    constexpr int NQL = 8;
#define SEAM_K0() do { VMWN(NQL); SWRITE_HK(0); SBAR(); } while (0)
    f32x16 pA0, pA1, pB0, pB1; float mnA, mnB, alA, alB; bf16x8 pa0, pa1, pa2, pa3;
    SWRITE_HV(0); SBAR();
    if (NT > 1) SLOAD_H(Kh, Vh, KBASE(1));
    SBAR(); qkt<0, true>(pA0, pA1, K_lds, r32, hi, S.qr, bias_l + KBASE(0));
    MASKT(pA0, pA1, 0); partialSM(pA0, pA1, m_reg, mnA, alA);
    if (NT > 1) { VMW(); SWRITE_H(1); }
    __syncthreads();
#define HALF_STEP(PX0, PX1, mnX, alX, PY0, PY1, alY, t, KB, VB, SB) do {                                                      \
        SBAR(); qkt<KB, true>(PX0, PX1, K_lds, r32, hi, S.qr, bias_l + KBASE(t));                                             \
        finishSM(PY0, PY1, alY, l_reg, pa0, pa1, pa2, pa3); SBAR();                                                           \
        if ((t) + 1 < NT) { SLOAD_H(Kh, Vh, KBASE((t) + 1)); SBAR(); }                                                        \
        pv_tile<VB>(o, vb0, pa0, pa1, pa2, pa3); MASKT(PX0, PX1, (t)); partialSM(PX0, PX1, m_reg, mnX, alX);                  \
        __syncthreads();                                                                                                      \
        if ((t) + 1 < NT) { VMW(); SWRITE_H(SB); }                                                                            \
        RESC(alX); __syncthreads(); } while (0)
    for (int t = 1; t + 1 < NT; t += 2) {
        HALF_STEP(pB0, pB1, mnB, alB, pA0, pA1, alA, t, 1, 0, 0);
        HALF_STEP(pA0, pA1, mnA, alA, pB0, pB1, alB, t + 1, 0, 1, 1);
    }
    const bool even = (NT & 1) == 0;
    if (even) { SBAR(); qkt<1, true>(pB0, pB1, K_lds, r32, hi, S.qr, bias_l + KBASE(NT - 1)); SBAR(); }
    SLOAD_H(nxt.K, nxt.V, 0); SBAR();
#pragma unroll
    for (int d0 = 0; d0 < 8; ++d0) S.qr[d0] = ld8(nxt.Q + (size_t)(wid * QBLK + r32) * D + d0 * 16 + hi * 8);
    SBAR();
    finishSM(pA0, pA1, alA, l_reg, pa0, pa1, pa2, pa3); SBAR();
    pv_tile<0>(o, vb0, pa0, pa1, pa2, pa3);
    if (even) { MASKT(pB0, pB1, NT - 1); partialSM(pB0, pB1, m_reg, mnB, alB); __syncthreads(); RESC(alB);
        finishSM(pB0, pB1, alB, l_reg, pa0, pa1, pa2, pa3); SBAR(); pv_tile<1>(o, vb0, pa0, pa1, pa2, pa3); }
    SBAR(); SEAM_K0();
    GATED_STORE(__builtin_amdgcn_rcpf(l_reg));
    __syncthreads();
#undef RESC
#undef MASKT
#undef SEAM_K0
#undef HALF_STEP
}
constexpr float SB_EXIT = 128.f;
__device__ __forceinline__ void sb_block(const BlockRef& cur, char* lds) {
    const int tid = otid(), wid = __builtin_amdgcn_readfirstlane(tid >> 6), lane = tid & 63, r32 = lane & 31, hi = lane >> 5;
    const int NT = (cur.P0 + QB) / KVBLK;
    const int qlo = cur.P0 + wid * QBLK, qm = qlo + r32 - 32 * hi - 1;
    char* V_lds = lds; char* K_lds = lds + 2 * SHM_V;
    volatile unsigned* flags = (volatile unsigned*)(lds + LDS_FLAGS);
    const int sr = tid >> 4, sc = (tid & 15) * 8, asr = key_of_slot(sr), vst0 = v_st(sr, sc), vst1 = v_st(32 + sr, sc), kws = KSWZ(sr, sc * 2);
    const int vb0 = (int)(uintptr_t)V_lds + v_rd_base(lane);
    const bf16* Kh = cur.K; const bf16* Vh = cur.V;
    Seam S;
#pragma unroll
    for (int d0 = 0; d0 < 8; ++d0) S.qr[d0] = ld8(cur.Q + (size_t)(wid * QBLK + r32) * D + d0 * 16 + hi * 8);
    float R = 0.f; f32x16 o[4] = {};
    int j = NT - 1;
    SLOAD_H(Kh, Vh, j * KVBLK); VMW(); SWRITE_H(0);
    __syncthreads();
    f32x16 p0, p1; bf16x8 pa0, pa1, pa2, pa3;
#define SB_STEP(KB, NB, PAR) {                                                                                                 \
        const bool more = j > 0; const int kb_ = j * KVBLK;                                                                   \
        if (more) { SLOAD_H(Kh, Vh, kb_ - KVBLK); SBAR(); }                                                                   \
        if (kb_ <= qlo + QBLK - 2) {                                       \
            qkt<KB, false>(p0, p1, K_lds, r32, hi, S.qr, nullptr);                                                            \
            if (kb_ + KVBLK - 1 > qlo - 1) mask_tile(p0, p1, qm - kb_);                                                       \
            sb_math(p0, p1, R, hi, pa0, pa1, pa2, pa3); SBAR();                                                               \
            pv_tile<KB>(o, vb0, pa0, pa1, pa2, pa3); }                                                                        \
        const unsigned dn = __all(R < -SB_EXIT) ? 1u : 0u;                                                                    \
        if (lane == 0) flags[(PAR) * 8 + wid] = dn;                                                                           \
        if (more) { VMW(); SWRITE_H(NB); }                                                                                    \
        __syncthreads();                                                                                                      \
        unsigned alld = flags[(PAR) * 8 + (lane & 7)]; alld = __all(alld != 0u) ? 1u : 0u;                                     \
        --j; if (!more || alld) break; }
    for (;;) { SB_STEP(0, 1, 0) SB_STEP(1, 0, 1) }
#undef SB_STEP
    GATED_STORE(1.0f);
    __syncthreads();
}
#undef ROW
#undef VMW
#undef VMWN
#undef SLOAD_H
#undef SWRITE_HK
#undef SWRITE_HV
#undef SWRITE_H
#undef GATED_STORE
#undef PK4
}
constexpr int NB = 8, SEQ = 4096, DM = 1024, DI = 2048, NH = 16, DEPTH = 4, FOXC = 4 * DI + NH, SBC = 4 * DI;
constexpr int MTOT = NB * SEQ, NHALF = 2, BH = NB / NHALF, MH = BH * SEQ;
constexpr float LN_EPS = 1e-5f, ALPHA = 1.681792830507429f  , LOG2E = 1.4426950408889634f, QSCALE = 0.08838834764831845f * LOG2E;
constexpr size_t MiB = 1u << 20;
constexpr size_t WS_LOGF = 1 * MiB;
constexpr size_t WS_CUM = 3 * MiB;
constexpr size_t WS_WIN = 8 * MiB;
constexpr size_t WS_WOUT = 72 * MiB;
constexpr size_t WS_XB = 88 * MiB;
constexpr size_t WS_QKVZ = 152 * MiB;
constexpr size_t WS_G = 408 * MiB;
constexpr size_t WS_END = 472 * MiB;
constexpr int LDS_MISC = 131072, LDS_TOTAL = LDS_MISC + 1024;
static_assert(att::LDS_BYTES <= LDS_MISC && pg8::STAGE_BYTES <= LDS_MISC, "LDS map");

struct Params { const float* x; const float* fox_w_in; const float* fox_b_f; const float* fox_w_out; const float* sb_w_in; const float* sb_w_out; const float* ln_g; const float* ln_b; float* out; unsigned char* ws; };

typedef float f32x4 __attribute__((ext_vector_type(4)));
typedef unsigned u32x4 __attribute__((ext_vector_type(4)));
typedef unsigned u32x2 __attribute__((ext_vector_type(2)));
__device__ __forceinline__ float wave_sum(float v) {
#pragma unroll
    for (int o = 32; o >= 1; o >>= 1) v += __shfl_xor(v, o);
    return v;
}
__device__ __forceinline__ void transpose_tile(const float* W, int ld, int K, unsigned short* Wt, int k0, int n0, float* scr  ) {
    const int t = otid();
    { const int kk = t >> 3, nn = (t & 7) * 8; const float* src = W + (size_t)(k0 + kk) * ld + n0 + nn;
      const f32x4 a = *(const f32x4*)src, b = *(const f32x4*)(src + 4); float* d = scr + kk * 65 + nn;
      d[0] = a[0]; d[1] = a[1]; d[2] = a[2]; d[3] = a[3]; d[4] = b[0]; d[5] = b[1]; d[6] = b[2]; d[7] = b[3]; }
    __syncthreads();
    { const int nn = t >> 3, kk = (t & 7) * 8; float v[8];
#pragma unroll
      for (int j = 0; j < 8; ++j) v[j] = scr[(kk + j) * 65 + nn];
      u32x4 w; w.x = pg8::cvt_pk_bf16(v[0], v[1]); w.y = pg8::cvt_pk_bf16(v[2], v[3]); w.z = pg8::cvt_pk_bf16(v[4], v[5]); w.w = pg8::cvt_pk_bf16(v[6], v[7]);
      *(u32x4*)(Wt + (size_t)(n0 + nn) * K + k0 + kk) = w; }
    __syncthreads();
}
__device__ __forceinline__ void row_phase(const float* src, float* dstf, unsigned short* xb, float* logf2, const float* g, const float* bta, const float* wf  , const float* bf,
                                          int row_lo, int row_hi, unsigned char* lds) {
    const int tid = otid(), wid = tid >> 6, lane = tid & 63;
    float* wl = (float*)lds;
    if (wf) { for (int i = tid; i < 1024 * 4; i += 512) { const int c = i >> 2, j = i & 3; const f32x4 w = *(const f32x4*)(wf + (size_t)c * FOXC + 8192 + 4 * j);
                  wl[(4 * j + 0) * 1024 + c] = w[0]; wl[(4 * j + 1) * 1024 + c] = w[1]; wl[(4 * j + 2) * 1024 + c] = w[2]; wl[(4 * j + 3) * 1024 + c] = w[3]; }
              __syncthreads(); }
    for (int r = row_lo + obid() * 8 + wid; r < row_hi; r += ogrid() * 8) {
        f32x4 v[4];
#pragma unroll
        for (int i = 0; i < 4; ++i) v[i] = *(const f32x4*)(src + (size_t)r * DM + i * 256 + lane * 4);
        if (g) {
            float s = 0.f;
#pragma unroll
            for (int i = 0; i < 4; ++i) s += (v[i][0] + v[i][1]) + (v[i][2] + v[i][3]);
            const float mu = wave_sum(s) * (1.0f / DM); float q = 0.f;
#pragma unroll
            for (int i = 0; i < 4; ++i) { v[i] = v[i] - mu; q += (v[i][0] * v[i][0] + v[i][1] * v[i][1]) + (v[i][2] * v[i][2] + v[i][3] * v[i][3]); }
            const float rstd = 1.0f / sqrtf(wave_sum(q) * (1.0f / DM) + LN_EPS);
#pragma unroll
            for (int i = 0; i < 4; ++i) { const f32x4 gg = *(const f32x4*)(g + i * 256 + lane * 4), bb = *(const f32x4*)(bta + i * 256 + lane * 4);
                v[i] = v[i] * rstd * gg + bb; *(f32x4*)(dstf + (size_t)r * DM + i * 256 + lane * 4) = v[i]; }
        }
        if (xb) {
#pragma unroll
            for (int i = 0; i < 4; ++i) { u32x2 w; w.x = pg8::cvt_pk_bf16(v[i][0], v[i][1]); w.y = pg8::cvt_pk_bf16(v[i][2], v[i][3]); *(u32x2*)(xb + (size_t)r * DM + i * 256 + lane * 4) = w; }
        }
        if (wf) {
            float mine = 0.f;
#pragma unroll
            for (int h = 0; h < 16; ++h) { float a = 0.f;
#pragma unroll
                for (int i = 0; i < 4; ++i) { const f32x4 w = *(const f32x4*)(wl + h * 1024 + i * 256 + lane * 4); a += (v[i][0] * w[0] + v[i][1] * w[1]) + (v[i][2] * w[2] + v[i][3] * w[3]); }
                a = wave_sum(a); if (lane == h) mine = a; }
            if (lane < 16) { const float xx = mine + bf[lane]; const float ls = fminf(xx, 0.f) - log1pf(expf(-fabsf(xx))); logf2[(size_t)r * 16 + lane] = ls * LOG2E; }
        }
    }
}
__device__ __forceinline__ void cumsum_seq(const float* lf  , float* cum, float* scr  ) {
    const int tid = otid(), wid = tid >> 6, lane = tid & 63;
    float v[8]; float run = 0.f;
#pragma unroll
    for (int i = 0; i < 8; ++i) { run += lf[(size_t)(tid * 8 + i) * 16]; v[i] = run; }
    float inc = run;
#pragma unroll
    for (int o = 1; o < 64; o <<= 1) { const float t = __shfl_up(inc, o); if (lane >= o) inc += t; }
    if (lane == 63) scr[wid] = inc;
    __syncthreads();
    float off = inc - run;
    for (int w = 0; w < wid; ++w) off += scr[w];
#pragma unroll
    for (int i = 0; i < 8; ++i) cum[tid * 8 + i] = v[i] + off;
    __syncthreads();
}


#define WS_PTRS(p) unsigned char* ws = (p).ws; float* logf2 = (float*)(ws + WS_LOGF); float* cum = (float*)(ws + WS_CUM); unsigned short* win = (unsigned short*)(ws + WS_WIN); unsigned short* wout = (unsigned short*)(ws + WS_WOUT); \
    unsigned short* xb = (unsigned short*)(ws + WS_XB); unsigned short* qkvz = (unsigned short*)(ws + WS_QKVZ); unsigned short* gbuf = (unsigned short*)(ws + WS_G);       \
    (void)logf2; (void)cum; (void)win; (void)wout; (void)xb; (void)qkvz; (void)gbuf
constexpr size_t PLANE = (size_t)MH * DI;
__device__ __forceinline__ int vcu_of(int G, int bx) { return (G % 8 == 0) ? (bx % 8) * (G / 8) + bx / 8 : bx; }

__device__ __forceinline__ void ph_prologue(const Params& p, unsigned char* lds) {
    WS_PTRS(p); const int G = ogrid(), bx = obid();
    constexpr int T_IN = (DM / 64) * (8192 / 64), T_OUT = (DI / 64) * (DM / 64), T_L = T_IN + T_OUT;
    for (int t = bx; t < DEPTH * T_L; t += G) {
        const int l = t / T_L, u = t % T_L, slot = l >> 1; const bool fox = (l & 1) == 0;
        if (u < T_IN) { const float* W = fox ? p.fox_w_in + (size_t)slot * DM * FOXC : p.sb_w_in + (size_t)slot * DM * SBC;
            transpose_tile(W, fox ? FOXC : SBC, DM, win + (size_t)l * 8192 * DM, (u % (DM / 64)) * 64, (u / (DM / 64)) * 64, (float*)lds); }
        else { const int uu = u - T_IN; const float* W = (fox ? p.fox_w_out : p.sb_w_out) + (size_t)slot * DI * DM;
            transpose_tile(W, DM, DI, wout + (size_t)l * DM * DI, (uu % (DI / 64)) * 64, (uu / (DI / 64)) * 64, (float*)lds); }
    }
    row_phase(p.x, nullptr, xb, logf2, nullptr, nullptr, p.fox_w_in, p.fox_b_f, 0, MTOT, lds);
}
__device__ __forceinline__ void ph_inproj(const Params& p, int hf, int l, unsigned char* lds) {
    WS_PTRS(p); const int G = ogrid(), bx = obid(); const bool fox = (l & 1) == 0;
    if (fox && bx < BH * NH) { const int b = bx / NH, h = bx % NH;
        cumsum_seq(logf2 + ((size_t)(hf * BH + b) * SEQ) * 16 + h, cum + (size_t)bx * SEQ, (float*)(lds + LDS_MISC)); }
    pg8::Gemm g{xb + (size_t)hf * MH * DM, win + (size_t)l * 8192 * DM, MH, 8192, DM}; pg8::StaticOrder S; S.init(MH, 8192, G, bx);
    pg8::EpiQKVZ E{qkvz, PLANE, QSCALE};
    pg8::gemm_phase<pg8::EpiQKVZ, pg8::StaticOrder, true, true>((PG8_LAS unsigned char*)lds, g, S, E);
}
__device__ __forceinline__ att::BlockRef blk_ref(unsigned short* qkvz, unsigned short* gbuf, const float* cum, int bh, int qb) {
    const size_t ho = (size_t)bh * SEQ * 128, qo = ho + (size_t)qb * att::QB * 128;
    att::BlockRef r; r.Q = qkvz + qo; r.K = qkvz + PLANE + ho; r.V = qkvz + 2 * PLANE + ho; r.Z = qkvz + 3 * PLANE + qo;
    r.G = gbuf + ((size_t)(bh / NH) * SEQ + (size_t)qb * att::QB) * DI + (bh % NH) * 128; r.cum = cum + (size_t)bh * SEQ; r.P0 = qb * att::QB; return r;
}
__device__ __forceinline__ void ph_fox(const Params& p, unsigned char* lds) {
    WS_PTRS(p); const int G = ogrid(), vcu = vcu_of(G, obid());
    constexpr int NQB = SEQ / att::QB, NX = NQB / 2, TOTAL = BH * NH * NX;
    int L = vcu; if (L >= TOTAL) return;
    int pass = 0;
    att::BlockRef cur = blk_ref(qkvz, gbuf, cum, L / NX, L % NX); att::Seam S;
    att::fox_prime(cur, (char*)lds, S);
    for (;;) {
        const bool more_pass = pass == 0, more_item = L + G < TOTAL, last = !more_pass && !more_item;
        int passn = pass + 1, Ln = L; if (!more_pass) { passn = 0; Ln = more_item ? L + G : L; }
        const int xn = Ln % NX; const att::BlockRef nxt = last ? cur : blk_ref(qkvz, gbuf, cum, Ln / NX, passn ? NQB - 1 - xn : xn);
        att::fox_block(cur, nxt, (char*)lds, S);
        if (last) break;
        cur = nxt; pass = passn; L = Ln;
    }
}
__device__ __forceinline__ void ph_sb(const Params& p, unsigned char* lds) {
    WS_PTRS(p); const int G = ogrid(), vcu = vcu_of(G, obid());
    constexpr int NQB = SEQ / att::QB, TOTAL = BH * NH * NQB;
    for (int L = vcu; L < TOTAL; L += G) { const att::BlockRef r = blk_ref(qkvz, gbuf, cum, L / NQB, L % NQB); att::sb_block(r, (char*)lds); }
}
__device__ __forceinline__ void ph_outproj(const Params& p, int hf, int l, unsigned char* lds) {
    WS_PTRS(p); const int G = ogrid(), bx = obid(); const size_t ro = (size_t)hf * MH * DM;
    pg8::Gemm g{gbuf, wout + (size_t)l * DM * DI, MH, DM, DI}; pg8::StaticOrder S; S.init(MH, DM, G, bx);
    pg8::EpiRes E{(l == 0 ? p.x : p.out) + ro, p.out + ro, ALPHA};
    pg8::gemm_phase<pg8::EpiRes, pg8::StaticOrder, true, true>((PG8_LAS unsigned char*)lds, g, S, E);
}
__device__ __forceinline__ void ph_rows(const Params& p, int hf, int l, unsigned char* lds) {
    WS_PTRS(p); const bool nfox = (l + 1 < DEPTH) && (((l + 1) & 1) == 0); const int ns = (l + 1) >> 1;
    row_phase(p.out, p.out, (l + 1 < DEPTH) ? xb : nullptr, logf2, p.ln_g + l * DM, p.ln_b + l * DM,
              nfox ? p.fox_w_in + (size_t)ns * DM * FOXC : nullptr, nfox ? p.fox_b_f + ns * NH : nullptr, hf * MH, hf * MH + MH, lds);
}


#define LAS __attribute__((address_space(3)))
#define XB_TMO      128
#define XB_XCNT(j)  (256  + 64 * (j))
#define XB_XSUB(j)  (1280 + 64 * (j))
#define XB_XGEN(j)  (2304 + 64 * (j))
#define XB_TOP      3328
#define XB_TOPGEN   3392
#define XCD_BAR_WORDS 3456
#define XB_SPIN_CAP (1u << 20)
__device__ __forceinline__ unsigned xb_ld(unsigned* p)              { return __hip_atomic_load(p, __ATOMIC_RELAXED, __HIP_MEMORY_SCOPE_AGENT); }
__device__ __forceinline__ unsigned xb_add(unsigned* p, unsigned v) { return __hip_atomic_fetch_add(p, v, __ATOMIC_RELAXED, __HIP_MEMORY_SCOPE_AGENT); }
__device__ __forceinline__ unsigned xb_xcc_id() { return (unsigned)__builtin_amdgcn_s_getreg((3 << 11) | 20) & 0xFu; }
#define XB_SPIN(cond, bar) do { unsigned _sp = 0; while (cond) { __builtin_amdgcn_s_sleep(1); \
    if ((++_sp & 255u) == 0u) { if (xb_ld(&(bar)[XB_TMO])) break; if (_sp > XB_SPIN_CAP) { atomicAdd(&(bar)[XB_TMO], 1u); break; } } } } while (0)
__device__ __forceinline__ void xcd_barrier_complete(unsigned* bar, unsigned x, unsigned& nloc, unsigned& nx) {
    const unsigned G = gridDim.x * gridDim.y * gridDim.z;
    unsigned sum, cnt, mine, sp = 0u;
    for (;;) {
        sum = 0u; cnt = 0u; mine = 0u;
#pragma unroll
        for (unsigned j = 0; j < 16; ++j) { const unsigned c = xb_ld(&bar[XB_XCNT(j)]); sum += c; cnt += (c > 0u) ? 1u : 0u; mine = (j == x) ? c : mine; }
        if (sum == G) break;
        __builtin_amdgcn_s_sleep(1);
        if ((++sp & 255u) == 0u) { if (xb_ld(&bar[XB_TMO])) break; if (sp > XB_SPIN_CAP) { atomicAdd(&bar[XB_TMO], 1u); break; } }
    }
    nloc = mine > 0u ? mine : 1u; nx = cnt > 0u ? cnt : 1u;
}
__device__ __forceinline__ void xcd_barrier(unsigned* bar, volatile LAS unsigned* st) {
    asm volatile("s_waitcnt vmcnt(0)" ::: "memory");
    __syncthreads();
    if (threadIdx.x == 0) {
        const unsigned x = xb_xcc_id();
        __builtin_amdgcn_s_waitcnt(0);
        unsigned nloc = st[0], nx = st[1];
        if (nloc == 0u) { xcd_barrier_complete(bar, x, nloc, nx); st[0] = nloc; st[1] = nx; }
        const unsigned old = xb_add(&bar[XB_XSUB(x)], 1u);
        const unsigned gen = old / nloc;
        if (old + 1u == (gen + 1u) * nloc) {
            __builtin_amdgcn_fence(__ATOMIC_RELEASE, "agent");
            asm volatile("s_waitcnt vmcnt(0)" ::: "memory");
            const unsigned og = xb_add(&bar[XB_TOP], 1u);
            const unsigned tg = og / nx;
            if (og + 1u == (tg + 1u) * nx) xb_add(&bar[XB_TOPGEN], 1u);
            else XB_SPIN(xb_ld(&bar[XB_TOPGEN]) == tg, bar);
            __builtin_amdgcn_fence(__ATOMIC_ACQUIRE, "agent");
            xb_add(&bar[XB_XGEN(x)], 1u);
            asm volatile("s_waitcnt vmcnt(0)" ::: "memory");
        } else {
            XB_SPIN(xb_ld(&bar[XB_XGEN(x)]) == gen, bar);
            __builtin_amdgcn_fence(__ATOMIC_ACQUIRE, "agent");
            asm volatile("s_waitcnt vmcnt(0)" ::: "memory");
        }
    }
    __syncthreads();
}

#ifndef N_LAUNCH_MODE
#define N_LAUNCH_MODE 1
#endif
#if N_LAUNCH_MODE == 0
__global__ void __launch_bounds__(512, 2) k_prologue(Params p) { extern __shared__ __attribute__((aligned(16))) unsigned char lds[]; ph_prologue(p, lds); }
__global__ void __launch_bounds__(512, 2) k_inproj(Params p, int hf, int l) { extern __shared__ __attribute__((aligned(16))) unsigned char lds[]; ph_inproj(p, hf, l, lds); }
__global__ void __launch_bounds__(512, 2) k_fox(Params p) { extern __shared__ __attribute__((aligned(16))) unsigned char lds[]; ph_fox(p, lds); }
__global__ void __launch_bounds__(512, 2) k_sb(Params p) { extern __shared__ __attribute__((aligned(16))) unsigned char lds[]; ph_sb(p, lds); }
__global__ void __launch_bounds__(512, 2) k_outproj(Params p, int hf, int l) { extern __shared__ __attribute__((aligned(16))) unsigned char lds[]; ph_outproj(p, hf, l, lds); }
__global__ void __launch_bounds__(512, 2) k_rows(Params p, int hf, int l) { extern __shared__ __attribute__((aligned(16))) unsigned char lds[]; ph_rows(p, hf, l, lds); }
#else
#ifndef REP_SYNC
#define REP_SYNC 1
#endif
#ifndef REP_INPROJ
#define REP_INPROJ 1
#endif
#ifndef REP_FOX
#define REP_FOX 1
#endif
#ifndef REP_SB
#define REP_SB 1
#endif
#define GSYNC() do { for (int rs_ = 0; rs_ < REP_SYNC; ++rs_) { PENV(); xcd_barrier((unsigned*)p.ws, (volatile LAS unsigned*)(lds + LDS_MISC + 512)); } } while (0)
#define PENV() const Params* pp_ = (const Params*)__builtin_amdgcn_kernarg_segment_ptr(); asm volatile("" : "+s"(pp_)); const Params& p = *pp_
__global__ void __launch_bounds__(512, 2) fox_sb_mega(Params p_unused) {
    extern __shared__ __attribute__((aligned(16))) unsigned char lds[];
    cg::grid_group grid = cg::this_grid();
    if (threadIdx.x < 2) ((volatile LAS unsigned*)(lds + LDS_MISC + 512))[threadIdx.x] = 0u;
    __syncthreads();
    { PENV(); if (threadIdx.x == 0) (void)xb_add((unsigned*)p.ws + XB_XCNT(xb_xcc_id()), 1u); }
    { PENV(); ph_prologue(p, lds); }
    grid.sync();
    GSYNC();
    for (int hf = 0; hf < NHALF; ++hf)
        for (int l = 0; l < DEPTH; ++l) {
            for (int rep = 0; rep < REP_INPROJ; ++rep) { PENV(); ph_inproj(p, hf, l, lds); }
            GSYNC();
            if ((l & 1) == 0) { for (int rep = 0; rep < REP_FOX; ++rep) { PENV(); ph_fox(p, lds); } } else { for (int rep = 0; rep < REP_SB; ++rep) { PENV(); ph_sb(p, lds); } }
            GSYNC();
            { PENV(); ph_outproj(p, hf, l, lds); }
            GSYNC();
            { PENV(); ph_rows(p, hf, l, lds); }
            GSYNC();
        }
}
#endif

extern "C" void kernel_launch(void* const* d_in, const int* in_sizes, int n_in, void* d_out, int out_size, void* d_ws, size_t ws_size, hipStream_t stream) {
    static int grid = 0;
    if (grid == 0) {
        if (n_in != 8 || in_sizes[0] != MTOT * DM || out_size != MTOT * DM || ws_size < WS_END) { fprintf(stderr, "kernel_launch: unexpected shapes (n_in %d, in0 %d, out %d, ws %zu)\n", n_in, n_in > 0 ? in_sizes[0] : -1, out_size, ws_size); grid = -1; return; }
        int dev = 0, cus = 0;
        (void)hipGetDevice(&dev); (void)hipDeviceGetAttribute(&cus, hipDeviceAttributeMultiprocessorCount, dev);
#if N_LAUNCH_MODE == 0
        bool ok = hipFuncSetAttribute((const void*)k_prologue, hipFuncAttributeMaxDynamicSharedMemorySize, LDS_TOTAL) == hipSuccess;
        ok = ok && hipFuncSetAttribute((const void*)k_inproj, hipFuncAttributeMaxDynamicSharedMemorySize, LDS_TOTAL) == hipSuccess;
        ok = ok && hipFuncSetAttribute((const void*)k_fox, hipFuncAttributeMaxDynamicSharedMemorySize, LDS_TOTAL) == hipSuccess;
        ok = ok && hipFuncSetAttribute((const void*)k_sb, hipFuncAttributeMaxDynamicSharedMemorySize, LDS_TOTAL) == hipSuccess;
        ok = ok && hipFuncSetAttribute((const void*)k_outproj, hipFuncAttributeMaxDynamicSharedMemorySize, LDS_TOTAL) == hipSuccess;
        ok = ok && hipFuncSetAttribute((const void*)k_rows, hipFuncAttributeMaxDynamicSharedMemorySize, LDS_TOTAL) == hipSuccess;
        if (!ok) { fprintf(stderr, "kernel_launch: hipFuncSetAttribute failed\n"); grid = -1; return; }
#else
        int per_cu = 0;
        if (hipFuncSetAttribute((const void*)fox_sb_mega, hipFuncAttributeMaxDynamicSharedMemorySize, LDS_TOTAL) != hipSuccess) { fprintf(stderr, "kernel_launch: hipFuncSetAttribute failed\n"); grid = -1; return; }
        if (hipOccupancyMaxActiveBlocksPerMultiprocessor(&per_cu, (const void*)fox_sb_mega, 512, LDS_TOTAL) != hipSuccess || per_cu < 1) { fprintf(stderr, "kernel_launch: occupancy query says %d\n", per_cu); }
        (void)hipGetLastError();
#endif
        grid = cus > 0 ? cus : 256;
    }
    if (grid < 0) return;
    Params p{};
    p.x = (const float*)d_in[0]; p.fox_w_in = (const float*)d_in[1]; p.fox_b_f = (const float*)d_in[2]; p.fox_w_out = (const float*)d_in[3];
    p.sb_w_in = (const float*)d_in[4]; p.sb_w_out = (const float*)d_in[5]; p.ln_g = (const float*)d_in[6]; p.ln_b = (const float*)d_in[7];
    p.out = (float*)d_out; p.ws = (unsigned char*)d_ws;
#if N_LAUNCH_MODE != 0
    if (hipMemsetAsync(d_ws, 0, 16384, stream) != hipSuccess) { fprintf(stderr, "kernel_launch: memset failed\n"); return; }
#endif
#if N_LAUNCH_MODE == 0
    k_prologue<<<grid, 512, LDS_TOTAL, stream>>>(p);
    for (int hf = 0; hf < NHALF; ++hf)
        for (int l = 0; l < DEPTH; ++l) {
            k_inproj<<<grid, 512, LDS_TOTAL, stream>>>(p, hf, l);
            if ((l & 1) == 0) k_fox<<<grid, 512, LDS_TOTAL, stream>>>(p); else k_sb<<<grid, 512, LDS_TOTAL, stream>>>(p);
            k_outproj<<<grid, 512, LDS_TOTAL, stream>>>(p, hf, l);
            k_rows<<<grid, 512, LDS_TOTAL, stream>>>(p, hf, l);
        }
#else
    void* args[] = {&p};
    hipError_t e = hipLaunchCooperativeKernel((const void*)fox_sb_mega, dim3(grid), dim3(512), args, LDS_TOTAL, stream);
    if (e != hipSuccess) fprintf(stderr, "cooperative launch failed: %s (grid %d)\n", hipGetErrorString(e), grid);
#endif
}
```

```cpp
#include <hip/hip_runtime.h>
#include <hip/hip_cooperative_groups.h>
#include <cstdio>
#include <cstdint>
namespace cg = cooperative_groups;
__device__ __forceinline__ int otid() { int t = threadIdx.x; asm volatile("" : "+v"(t)); return t; }
__device__ __forceinline__ int obid() { int t = blockIdx.x; asm volatile("" : "+s"(t)); return t; }
__device__ __forceinline__ int ogrid() { int t = gridDim.x; asm volatile("" : "+s"(t)); return t; }
namespace pg8 {
#define PG8_LAS __attribute__((address_space(3)))
typedef unsigned short bf16_t;
typedef short bf16x8 __attribute__((ext_vector_type(8)));
typedef float f32x4 __attribute__((ext_vector_type(4)));
typedef unsigned u32x4 __attribute__((ext_vector_type(4)));
constexpr int BM = 256, BK = 64, HALF = 128, HTB = HALF * BK * 2  , STAGE_BYTES = 8 * HTB, NXCD = 8, WGM = 8;

__host__ __device__ __forceinline__ int lds_byte(int r, int c) { const int st = (r >> 4) * 2 + (c >> 5), rr = r & 15, cc = c & 31, ob = rr * 64 + cc * 2; return st * 1024 + (ob ^ (((ob >> 9) & 1) << 5)); }
__host__ __device__ __forceinline__ void stage_rc(int b, int& R, int& C) { const int st = b / 1024, sb = b % 1024, swz = sb ^ (((sb >> 9) & 1) << 5); R = (st >> 1) * 16 + swz / 64; C = (st & 1) * 32 + (swz % 64) / 2; }
__host__ __device__ __forceinline__ int perm32(int rho) { const int n = rho >> 4, i = rho & 15; return 8 * (i >> 2) + 4 * n + (i & 3); }

struct Unit { int pm, pn; };
struct Gemm { const bf16_t* A; const bf16_t* Bt; int M, N, K; };

struct StaticOrder {
    int nM, nN, nwg, G, c;
    __host__ __device__ void init(int M, int N, int G_, int c_) { nM = M / BM; nN = N / BM; nwg = nM * nN; G = G_; c = c_; }
    __host__ __device__ bool next(int i, Unit& u) const {
        const long L = (long)i * G + c; if (L >= nwg) return false;
        int wgid = (int)L; { const int q = nwg / NXCD, r = nwg % NXCD, xcd = wgid % NXCD, off = wgid / NXCD; wgid = (xcd < r ? xcd * (q + 1) : r * (q + 1) + (xcd - r) * q) + off; }
        const int nig = WGM * nN, gid = wgid / nig, fm = gid * WGM, gsz = (nM - fm) < WGM ? (nM - fm) : WGM;
        u.pm = fm + ((wgid % nig) % gsz); u.pn = (wgid % nig) / gsz; return true;
    }
    __device__ __forceinline__ void a_ready(const Unit&) const {}
    __device__ __forceinline__ void done(const Unit&) const {}
};

__device__ __forceinline__ unsigned cvt_pk_bf16(float lo, float hi) { unsigned r; asm volatile("v_cvt_pk_bf16_f32 %0, %1, %2" : "=v"(r) : "v"(lo), "v"(hi)); return r; }
struct EpiQKVZ {
    static constexpr bool PERM = true, AFTER_DRAIN = false;
    bf16_t* O; size_t wstride; float qscale;
    __device__ __forceinline__ void operator()(const f32x4 (&acc)[2][2][4][2], const Unit& u, int wr, int wc, int fr, int fq) const {
        const int row0 = u.pm * BM + wr * 64 + fr; const int colt = u.pn * BM; const int which = colt >> 11; const int head0 = (colt & 2047) >> 7;
        const int d0 = wc * 32 + 8 * fq; bf16_t* base = O + (size_t)which * wstride;
#pragma unroll
        for (int ai = 0; ai < 2; ++ai)
#pragma unroll
            for (int m = 0; m < 4; ++m) { const int r = row0 + ai * HALF + m * 16; const int b = r >> 12, s = r & 4095;
#pragma unroll
                for (int bj = 0; bj < 2; ++bj) { bf16_t* ptr = base + ((size_t)((b * 16 + head0 + bj) * 4096 + s)) * 128 + d0;
                    f32x4 v0 = acc[ai][bj][m][0], v1 = acc[ai][bj][m][1];
                    if (which == 0) { v0 = v0 * qscale; v1 = v1 * qscale; }
                    if (which == 3) {
#pragma unroll
                        for (int j = 0; j < 4; ++j) { v0[j] = v0[j] * __builtin_amdgcn_rcpf(1.0f + __builtin_amdgcn_exp2f(-1.4426950408889634f * v0[j]));
                                                      v1[j] = v1[j] * __builtin_amdgcn_rcpf(1.0f + __builtin_amdgcn_exp2f(-1.4426950408889634f * v1[j])); } }
                    u32x4 w; w.x = cvt_pk_bf16(v0[0], v0[1]); w.y = cvt_pk_bf16(v0[2], v0[3]); w.z = cvt_pk_bf16(v1[0], v1[1]); w.w = cvt_pk_bf16(v1[2], v1[3]);
                    *(u32x4*)ptr = w; } }
    }
};
struct EpiRes {
    static constexpr bool PERM = false, AFTER_DRAIN = false;
    const float* xres; float* out; float alpha;
    __device__ __forceinline__ void operator()(const f32x4 (&acc)[2][2][4][2], const Unit& u, int wr, int wc, int fr, int fq) const {
        const int row0 = u.pm * BM + wr * 64 + fr; const int col0 = u.pn * BM + wc * 32 + 4 * fq;
#pragma unroll
        for (int ai = 0; ai < 2; ++ai)
#pragma unroll
            for (int m = 0; m < 4; ++m) { const size_t ro = (size_t)(row0 + ai * HALF + m * 16) * 1024;
#pragma unroll
                for (int bj = 0; bj < 2; ++bj)
#pragma unroll
                    for (int n = 0; n < 2; ++n) { const size_t o = ro + col0 + bj * HALF + 16 * n;
                        const f32x4 xr = *(const f32x4*)(xres + o); *(f32x4*)(out + o) = xr * alpha + acc[ai][bj][m][n]; } }
    }
};

template <class Epi, class Sched, bool ALIGN_EPI = false, bool SP2 = false>
__device__ __forceinline__ void gemm_phase(PG8_LAS unsigned char* lds, const Gemm g, const Sched& S, const Epi& E) {
    const int tid = otid(), wid = __builtin_amdgcn_readfirstlane(tid >> 6), lane = tid & 63, wr = wid >> 2, wc = wid & 3, fr = lane & 15, fq = lane >> 4;
    const int K = g.K, nt = K / BK;
    unsigned voffA[2], voffB[2];
#pragma unroll
    for (int i = 0; i < 2; ++i) { int R, C; stage_rc(tid * 16 + i * 8192, R, C); const int Rb = Epi::PERM ? ((R & ~31) + perm32(R & 31)) : R;
        voffA[i] = (unsigned)(R * K + C) * 2u; voffB[i] = (unsigned)(Rb * K + C) * 2u; }
    const size_t kstep = (size_t)(BK * 2);
    const size_t hstep = (size_t)HALF * K * 2;
    const size_t tstep = 2 * hstep;
    const unsigned ldsw = (unsigned)wid * 1024u;
    const int aoff = lds_byte(wr * 64 + fr, fq * 8), boff = lds_byte(wc * 32 + fr, fq * 8);
#define PG8_SA(b, h) (((b) * 2 + (h)) * HTB)
#define PG8_SB(b, h) ((4 + (b) * 2 + (h)) * HTB)
#define PG8_STAGE(bufoff, gbase, voff) do { _Pragma("unroll") for (int _i = 0; _i < 2; ++_i) \
        __builtin_amdgcn_global_load_lds((const unsigned*)((const char*)(gbase) + (voff)[_i]), (PG8_LAS unsigned*)(lds + (bufoff) + ldsw + _i * 8192), 16, 0, 0); } while (0)
#define PG8_LDA(dst, b, h) do { _Pragma("unroll") for (int m = 0; m < 4; ++m) _Pragma("unroll") for (int k = 0; k < 2; ++k) dst[m][k] = *(const PG8_LAS bf16x8*)(lds + PG8_SA(b, h) + aoff + m * 2048 + k * 1024); } while (0)
#define PG8_LDB(dst, b, h) do { _Pragma("unroll") for (int n = 0; n < 2; ++n) _Pragma("unroll") for (int k = 0; k < 2; ++k) dst[n][k] = *(const PG8_LAS bf16x8*)(lds + PG8_SB(b, h) + boff + n * 2048 + k * 1024); } while (0)
#define PG8_MMA(ai, bj, At, Bt) do { __builtin_amdgcn_s_setprio(1); _Pragma("unroll") for (int m = 0; m < 4; ++m) _Pragma("unroll") for (int n = 0; n < 2; ++n) _Pragma("unroll") for (int k = 0; k < 2; ++k) \
        acc[ai][bj][m][n] = __builtin_amdgcn_mfma_f32_16x16x32_bf16(Bt[n][k], At[m][k], acc[ai][bj][m][n], 0, 0, 0); __builtin_amdgcn_s_setprio(0); } while (0)
#define PG8_WAIT_V(n) asm volatile("s_waitcnt vmcnt(" #n ")" ::: "memory")
#define PG8_WAIT_L(n) asm volatile("s_waitcnt lgkmcnt(" #n ")" ::: "memory")
#define PG8_BAR __builtin_amdgcn_s_barrier()
#define PG8_SCHED __builtin_amdgcn_sched_barrier(0)
    Unit cur, nxt; int ui = 0;
    if (!S.next(0, cur)) return;
    f32x4 acc[2][2][4][2];
#pragma unroll
    for (int a = 0; a < 2; ++a)
#pragma unroll
        for (int b = 0; b < 2; ++b)
#pragma unroll
            for (int m = 0; m < 4; ++m)
#pragma unroll
                for (int n = 0; n < 2; ++n) acc[a][b][m][n] = (f32x4){0.f, 0.f, 0.f, 0.f};
    bf16x8 At[4][2], B0[2][2], B1[2][2];
    const char* cA = (const char*)g.A + (size_t)cur.pm * tstep; const char* cB = (const char*)g.Bt + (size_t)cur.pn * tstep;
    S.a_ready(cur);
    if constexpr (SP2) {
        PG8_STAGE(PG8_SB(0, 0), cB, voffB); PG8_STAGE(PG8_SB(0, 1), cB + hstep, voffB); PG8_STAGE(PG8_SA(0, 0), cA, voffA); PG8_STAGE(PG8_SA(0, 1), cA + hstep, voffA);
        if (wr == 1) PG8_BAR;
        PG8_WAIT_V(2); PG8_BAR;
        PG8_STAGE(PG8_SB(1, 0), cB + kstep, voffB); PG8_STAGE(PG8_SA(1, 0), cA + kstep, voffA); PG8_STAGE(PG8_SB(1, 1), cB + hstep + kstep, voffB);
        PG8_WAIT_V(6); PG8_BAR;
    } else {
        PG8_STAGE(PG8_SB(0, 0), cB, voffB); PG8_STAGE(PG8_SA(0, 0), cA, voffA); PG8_STAGE(PG8_SB(0, 1), cB + hstep, voffB); PG8_STAGE(PG8_SA(0, 1), cA + hstep, voffA);
        if (wr == 1) PG8_BAR;
        PG8_WAIT_V(4); PG8_BAR;
        PG8_STAGE(PG8_SB(1, 0), cB + kstep, voffB); PG8_STAGE(PG8_SA(1, 0), cA + kstep, voffA); PG8_STAGE(PG8_SB(1, 1), cB + hstep + kstep, voffB);
        PG8_WAIT_V(6); PG8_BAR;
    }
    for (;;) {
        const bool has_next = S.next(ui + 1, nxt);
        const char* nA = has_next ? (const char*)g.A + (size_t)nxt.pm * tstep : cA; const char* nB = has_next ? (const char*)g.Bt + (size_t)nxt.pn * tstep : cB;
        for (int t = 0; t < nt; t += 2) {
            const bool last = (t == nt - 2);
            const char* a1 = cA + (size_t)(t + 1) * kstep;
            const char* a2 = last ? nA : cA + (size_t)(t + 2) * kstep; const char* b2 = last ? nB : cB + (size_t)(t + 2) * kstep;
            const char* a3 = a2 + kstep; const char* b3 = b2 + kstep;
            if (last && has_next) S.a_ready(nxt);
            if constexpr (SP2) {
            PG8_LDB(B0, 0, 0); PG8_LDB(B1, 0, 1); PG8_SCHED; PG8_LDA(At, 0, 0); PG8_STAGE(PG8_SA(1, 1), a1 + hstep, voffA);
            PG8_WAIT_V(8); PG8_WAIT_L(0); PG8_BAR; PG8_MMA(0, 0, At, B0); PG8_MMA(0, 1, At, B1); PG8_BAR; PG8_SCHED;
            PG8_LDA(At, 0, 1); PG8_STAGE(PG8_SB(0, 0), b2, voffB); PG8_STAGE(PG8_SB(0, 1), b2 + hstep, voffB); PG8_STAGE(PG8_SA(0, 0), a2, voffA);
            PG8_WAIT_V(8); PG8_WAIT_L(0); PG8_BAR; PG8_MMA(1, 0, At, B0); PG8_MMA(1, 1, At, B1); PG8_BAR; PG8_SCHED;
            PG8_LDB(B0, 1, 0); PG8_LDB(B1, 1, 1); PG8_SCHED; PG8_LDA(At, 1, 0); PG8_STAGE(PG8_SA(0, 1), a2 + hstep, voffA);
            PG8_WAIT_V(8); PG8_WAIT_L(0); PG8_BAR; PG8_MMA(0, 0, At, B0); PG8_MMA(0, 1, At, B1); PG8_BAR; PG8_SCHED;
            PG8_LDA(At, 1, 1); PG8_STAGE(PG8_SB(1, 0), b3, voffB); PG8_STAGE(PG8_SB(1, 1), b3 + hstep, voffB); PG8_STAGE(PG8_SA(1, 0), a3, voffA);
            PG8_WAIT_V(8); PG8_WAIT_L(0); PG8_BAR; PG8_MMA(1, 0, At, B0); PG8_MMA(1, 1, At, B1); PG8_BAR; PG8_SCHED;
            } else {
            PG8_LDB(B0, 0, 0); PG8_SCHED; PG8_LDA(At, 0, 0); PG8_STAGE(PG8_SA(1, 1), a1 + hstep, voffA);
            PG8_WAIT_L(8); PG8_BAR; PG8_WAIT_L(0); PG8_MMA(0, 0, At, B0); PG8_BAR; PG8_SCHED;
            PG8_LDB(B1, 0, 1); PG8_STAGE(PG8_SB(0, 0), b2, voffB);
            PG8_BAR; PG8_WAIT_L(0); PG8_MMA(0, 1, At, B1); PG8_BAR;
            PG8_LDA(At, 0, 1); PG8_STAGE(PG8_SA(0, 0), a2, voffA);
            PG8_BAR; PG8_WAIT_L(0); PG8_MMA(1, 0, At, B0); PG8_BAR; PG8_SCHED;
            PG8_STAGE(PG8_SB(0, 1), b2 + hstep, voffB);
            PG8_WAIT_V(6); PG8_BAR; PG8_MMA(1, 1, At, B1); PG8_BAR;
            PG8_LDB(B0, 1, 0); PG8_SCHED; PG8_LDA(At, 1, 0); PG8_STAGE(PG8_SA(0, 1), a2 + hstep, voffA);
            PG8_WAIT_L(8); PG8_BAR; PG8_WAIT_L(0); PG8_MMA(0, 0, At, B0); PG8_BAR; PG8_SCHED;
            PG8_LDB(B1, 1, 1); PG8_STAGE(PG8_SB(1, 0), b3, voffB);
            PG8_BAR; PG8_WAIT_L(0); PG8_MMA(0, 1, At, B1); PG8_BAR;
            PG8_LDA(At, 1, 1); PG8_STAGE(PG8_SA(1, 0), a3, voffA);
            PG8_BAR; PG8_WAIT_L(0); PG8_MMA(1, 0, At, B0); PG8_BAR; PG8_SCHED;
            PG8_STAGE(PG8_SB(1, 1), b3 + hstep, voffB);
            PG8_WAIT_V(6); PG8_BAR; PG8_MMA(1, 1, At, B1); PG8_BAR;
            }
        }
        if constexpr (ALIGN_EPI) { if (wr == 0) PG8_BAR; }
        if constexpr (!Epi::AFTER_DRAIN) { E(acc, cur, wr, wc, fr, fq); S.done(cur); }
        if (!has_next) break;
#pragma unroll
        for (int a = 0; a < 2; ++a)
#pragma unroll
            for (int b = 0; b < 2; ++b)
#pragma unroll
                for (int m = 0; m < 4; ++m)
#pragma unroll
                    for (int n = 0; n < 2; ++n) acc[a][b][m][n] = (f32x4){0.f, 0.f, 0.f, 0.f};
        cur = nxt; cA = nA; cB = nB; ++ui;
        if constexpr (ALIGN_EPI) { if (wr == 1) PG8_BAR; }
    }
    PG8_WAIT_V(0);
    if constexpr (!ALIGN_EPI) { if (wr == 0) PG8_BAR; }
    PG8_BAR;
    if constexpr (Epi::AFTER_DRAIN) { E.fused(acc, cur, wr, wc, fr, fq, lds, wid, lane); S.done(cur); }
#undef PG8_SA
#undef PG8_SB
#undef PG8_STAGE
#undef PG8_LDA
#undef PG8_LDB
#undef PG8_MMA
#undef PG8_WAIT_V
#undef PG8_WAIT_L
#undef PG8_BAR
#undef PG8_SCHED
}
}
namespace att {
constexpr int D = 128, NW = 8, QBLK = 32, KVBLK = 64, QB = NW * QBLK, SEQ = 4096, GP = 2048  ;
constexpr int SHM_V = KVBLK * D * 2, SHM_K = KVBLK * D * 2;
constexpr int LDS_WS = 2 * SHM_V + 2 * SHM_K, LDS_BIAS = LDS_WS + NW * 64 * 4, LDS_FLAGS = LDS_BIAS + SEQ * 4, LDS_QHI = LDS_FLAGS + 64, LDS_BYTES = LDS_QHI + NW * 4096;
typedef unsigned short bf16;
typedef short bf16x8 __attribute__((ext_vector_type(8)));
typedef short s16x4 __attribute__((ext_vector_type(4)));
typedef float f32x16 __attribute__((ext_vector_type(16)));
typedef float f32x4 __attribute__((ext_vector_type(4)));
typedef unsigned u32x4 __attribute__((ext_vector_type(4)));
typedef unsigned u32x2 __attribute__((ext_vector_type(2)));
#define KSWZ(row, colB) ((row) * 256 + ((colB) ^ (((row) & 7) << 4)))
#define SBAR() __builtin_amdgcn_sched_barrier(0)
__device__ __forceinline__ int v_st(int k, int c) { const int kk = (k & ~0xC) | ((k & 4) << 1) | ((k & 8) >> 1); return ((kk >> 3) * 4 + (c >> 5)) * 512 + ((kk & 7) * 32 + (c & 31)) * 2; }
__device__ __forceinline__ int v_rd_base(int lane) { return ((lane & 3) << 3) | (((lane >> 2) & 3) << 6) | (((lane >> 4) & 1) << 5) | (((lane >> 5) & 1) << 8); }
constexpr int v_rd_off(int d0, int ks, int half) { return d0 * 512 + ks * 4096 + half * 2048; }
__device__ __forceinline__ int crow(int r, int hi) { return (r & 3) + 8 * (r >> 2) + 4 * hi; }
__device__ __forceinline__ unsigned cvtpk(float lo, float hi) { unsigned r; asm volatile("v_cvt_pk_bf16_f32 %0, %1, %2" : "=v"(r) : "v"(lo), "v"(hi)); return r; }
__device__ __forceinline__ bf16x8 ld8(const bf16* p) { return *reinterpret_cast<const bf16x8*>(p); }
__device__ __forceinline__ float bf2f(bf16 v) { return __uint_as_float((unsigned)v << 16); }
__device__ __forceinline__ int key_of_slot(int sr) { return ((sr >> 2) & 1) * 32 + (sr & 3) + ((sr >> 3) << 2); }
__device__ __forceinline__ void mask_tile(f32x16& p0, f32x16& p1, int dq) {
    const float NEG = -__builtin_inff();
#pragma unroll
    for (int r = 0; r < 16; ++r) { if (r > dq) p0[r] = NEG; if (r + 16 > dq) p1[r] = NEG; }
}
constexpr float THR2 = 11.5f;
__device__ __forceinline__ void partialSM(f32x16& p0, f32x16& p1, float& m_reg, float& mn, float& alpha) {
    float pmax = p0[0];
#pragma unroll
    for (int r = 1; r < 16; ++r) pmax = fmaxf(pmax, p0[r]);
#pragma unroll
    for (int r = 0; r < 16; ++r) pmax = fmaxf(pmax, p1[r]);
    { auto rr = __builtin_amdgcn_permlane32_swap(__float_as_uint(pmax), __float_as_uint(pmax), false, false);
      pmax = fmaxf(__uint_as_float(rr[0]), __uint_as_float(rr[1])); }
    if (__builtin_expect(__all((pmax - m_reg) <= THR2), 1)) { mn = m_reg; alpha = 1.f; }
    else { mn = fmaxf(m_reg, pmax); alpha = __builtin_amdgcn_exp2f(m_reg - mn); m_reg = mn; }
#pragma unroll
    for (int r = 0; r < 16; ++r) p0[r] = p0[r] - mn;
#pragma unroll
    for (int r = 0; r < 16; ++r) p1[r] = p1[r] - mn;
#pragma unroll
    for (int r = 0; r < 16; ++r) p0[r] = __builtin_amdgcn_exp2f(p0[r]);
}
#define PK4(P, B_, OUT) do { unsigned a0 = cvtpk(P[B_+0], P[B_+1]), a1 = cvtpk(P[B_+2], P[B_+3]);                          \
        unsigned b0 = cvtpk(P[B_+4], P[B_+5]), b1 = cvtpk(P[B_+6], P[B_+7]);                                             \
        auto r0 = __builtin_amdgcn_permlane32_swap(a0, b0, false, false); auto r1 = __builtin_amdgcn_permlane32_swap(a1, b1, false, false); \
        u32x4 w = {r0[0], r1[0], r0[1], r1[1]}; OUT = *reinterpret_cast<bf16x8*>(&w); } while (0)
__device__ __forceinline__ void finishSM(f32x16& p0, f32x16& p1, float alpha, float& l_reg, bf16x8& pa0, bf16x8& pa1, bf16x8& pa2, bf16x8& pa3) {
#pragma unroll
    for (int r = 0; r < 16; ++r) p1[r] = __builtin_amdgcn_exp2f(p1[r]);
    float ps = 0;
#pragma unroll
    for (int r = 0; r < 16; ++r) ps += p0[r];
#pragma unroll
    for (int r = 0; r < 16; ++r) ps += p1[r];
    { auto rr = __builtin_amdgcn_permlane32_swap(__float_as_uint(ps), __float_as_uint(ps), false, false);
      ps = __uint_as_float(rr[0]) + __uint_as_float(rr[1]); }
    l_reg = l_reg * alpha + ps;
    PK4(p0, 0, pa0); PK4(p0, 8, pa1); PK4(p1, 0, pa2); PK4(p1, 8, pa3);
}
__device__ __forceinline__ void sb_math(f32x16& p0, f32x16& p1, float& R, int hi, bf16x8& pa0, bf16x8& pa1, bf16x8& pa2, bf16x8& pa3) {
    float run = 0.f;
#pragma unroll
    for (int r = 15; r >= 0; --r) { const float z = fminf(p1[r], 64.f); run -= __builtin_amdgcn_logf(1.0f + __builtin_amdgcn_exp2f(z)); p1[r] = z + run; }
#pragma unroll
    for (int r = 15; r >= 0; --r) { const float z = fminf(p0[r], 64.f); run -= __builtin_amdgcn_logf(1.0f + __builtin_amdgcn_exp2f(z)); p0[r] = z + run; }
    const auto rr = __builtin_amdgcn_permlane32_swap(__float_as_uint(run), __float_as_uint(run), false, false);
    const float partner = hi ? __uint_as_float(rr[0]) : __uint_as_float(rr[1]);
    const float base = hi ? R : R + partner;
    R = R + (run + partner);
#pragma unroll
    for (int r = 0; r < 16; ++r) p0[r] = __builtin_amdgcn_exp2f(p0[r] + base);
#pragma unroll
    for (int r = 0; r < 16; ++r) p1[r] = __builtin_amdgcn_exp2f(p1[r] + base);
    PK4(p0, 0, pa0); PK4(p0, 8, pa1); PK4(p1, 0, pa2); PK4(p1, 8, pa3);
}
template <int KB, bool BIAS, bool QHI = false>
__device__ __forceinline__ void qkt(f32x16& p0, f32x16& p1, const char* K_lds, int r32, int hi, const bf16x8* qr, const float* bias_t, const char* qhi = nullptr) {
    if constexpr (BIAS) {
#pragma unroll
        for (int i = 0; i < 4; ++i) { const f32x4 a = *(const f32x4*)(bias_t + 4 * i), b = *(const f32x4*)(bias_t + 16 + 4 * i);
            p0[4 * i] = a[0]; p0[4 * i + 1] = a[1]; p0[4 * i + 2] = a[2]; p0[4 * i + 3] = a[3]; p1[4 * i] = b[0]; p1[4 * i + 1] = b[1]; p1[4 * i + 2] = b[2]; p1[4 * i + 3] = b[3]; }
    } else { p0 = f32x16{}; p1 = f32x16{}; }
    const char* kb[4];
#pragma unroll
    for (int dd = 0; dd < 4; ++dd) kb[dd] = K_lds + KB * SHM_K + KSWZ(r32, (dd * 16 + hi * 8) * 2);
#pragma unroll
    for (int d0 = 0; d0 < 8; ++d0) { const char* a = kb[d0 & 3] + (d0 >> 2) * 128;
        bf16x8 b0 = *reinterpret_cast<const bf16x8*>(a);
        bf16x8 b1 = *reinterpret_cast<const bf16x8*>(a + 32 * 256);
        bf16x8 qv; if (QHI && d0 >= 4) qv = *reinterpret_cast<const bf16x8*>(qhi + (d0 - 4) * 1024); else qv = qr[d0];
        p0 = __builtin_amdgcn_mfma_f32_32x32x16_bf16(b0, qv, p0, 0, 0, 0);
        p1 = __builtin_amdgcn_mfma_f32_32x32x16_bf16(b1, qv, p1, 0, 0, 0); }
}
template <int VB>
__device__ __forceinline__ void pv_tile(f32x16* o, int vb0, bf16x8 pa0, bf16x8 pa1, bf16x8 pa2, bf16x8 pa3) {
#define TRRD(dst, off) asm volatile("ds_read_b64_tr_b16 %0, %1 offset:%2" : "=&v"(dst) : "v"(vb0), "i"(off) : "memory")
#define PV_D0(d0) do { s16x4 l0, l1, l2, l3, h0, h1, h2, h3; constexpr int b_ = VB * SHM_V + v_rd_off(d0, 0, 0);   \
        TRRD(l0, b_); TRRD(h0, b_ + 2048); TRRD(l1, b_ + 4096); TRRD(h1, b_ + 6144); TRRD(l2, b_ + 8192); TRRD(h2, b_ + 10240); TRRD(l3, b_ + 12288); TRRD(h3, b_ + 14336); \
        asm volatile("s_waitcnt lgkmcnt(0)" ::: "memory"); SBAR();   \
        o[d0] = __builtin_amdgcn_mfma_f32_32x32x16_bf16((bf16x8){l0[0], l0[1], l0[2], l0[3], h0[0], h0[1], h0[2], h0[3]}, pa0, o[d0], 0, 0, 0);   \
        o[d0] = __builtin_amdgcn_mfma_f32_32x32x16_bf16((bf16x8){l1[0], l1[1], l1[2], l1[3], h1[0], h1[1], h1[2], h1[3]}, pa1, o[d0], 0, 0, 0);   \
        o[d0] = __builtin_amdgcn_mfma_f32_32x32x16_bf16((bf16x8){l2[0], l2[1], l2[2], l2[3], h2[0], h2[1], h2[2], h2[3]}, pa2, o[d0], 0, 0, 0);   \
        o[d0] = __builtin_amdgcn_mfma_f32_32x32x16_bf16((bf16x8){l3[0], l3[1], l3[2], l3[3], h3[0], h3[1], h3[2], h3[3]}, pa3, o[d0], 0, 0, 0); } while (0)
    PV_D0(0); PV_D0(1); PV_D0(2); PV_D0(3);
#undef PV_D0
#undef TRRD
}
constexpr size_t VOFF = (size_t)4 * 16 * 4096 * 128, ZOFF = 3 * VOFF;
struct BlockRef { const bf16* Q; const bf16* K; bf16* G; const float* cum; int P0; int j0; };
struct Queue { unsigned* ctr; int x; int nperq;
    __device__ __forceinline__ int fetch() const {
_Pragma("unroll 1")
        for (int k = 0; k < 8; ++k) { const int xq = (x + k) & 7; const unsigned old = __hip_atomic_fetch_add(ctr + xq * 16, 1u, __ATOMIC_RELAXED, __HIP_MEMORY_SCOPE_AGENT);
            if (old < (unsigned)nperq) return xq * nperq + (int)old; } return -1; } };
struct Seam { bf16x8 qr[4]; bf16x8 st_v0, st_v1, st_k0, st_k1; };
struct SeamSB { bf16x8 qr[8]; bf16x8 st_v0, st_v1, st_k0, st_k1; };
#define ROW(p, k0, rr) ((p) + (size_t)((k0) + (rr)) * D + sc)
#define VMW() asm volatile("s_waitcnt vmcnt(0)" ::: "memory")
#define VMWN(n) asm volatile("s_waitcnt vmcnt(%0)" :: "i"(n) : "memory")
#define SLOAD_H(Kp, Vp, k0) do { S.st_v0 = ld8(ROW(Vp, k0, asr)); S.st_v1 = ld8(ROW(Vp, k0, asr + 16));              \
                                 S.st_k0 = ld8(ROW(Kp, k0, asr)); S.st_k1 = ld8(ROW(Kp, k0, asr + 16)); } while (0)
#define SWRITE_HK(bf) do { *(bf16x8*)(K_lds + (bf) * SHM_K + kws) = S.st_k0; *(bf16x8*)(K_lds + (bf) * SHM_K + kws + 32 * 256) = S.st_k1; } while (0)
#define SWRITE_HV(bf) do { *(bf16x8*)(V_lds + (bf) * SHM_V + vst0) = S.st_v0; *(bf16x8*)(V_lds + (bf) * SHM_V + vst1) = S.st_v1; } while (0)
#define SWRITE_H(bf) do { SWRITE_HV(bf); SWRITE_HK(bf); } while (0)
#define GATED_STORE(RL) do { const float rl_ = (RL); const bf16* Zw = cur.Q + ZOFF + (size_t)(wid * QBLK + r32) * D + 4 * hi; bf16* Gw = cur.G + (size_t)(wid * QBLK + r32) * GP + 4 * hi;   \
    _Pragma("unroll") for (int d0 = 0; d0 < 4; ++d0) { _Pragma("unroll") for (int g_ = 0; g_ < 4; ++g_) { const u32x2 zz = *(const u32x2*)(Zw + d0 * 32 + 8 * g_);                            \
        const float v0 = o[d0][4 * g_ + 0] * rl_ * __uint_as_float(zz.x << 16), v1 = o[d0][4 * g_ + 1] * rl_ * __uint_as_float(zz.x & 0xffff0000u);                                       \
        const float v2 = o[d0][4 * g_ + 2] * rl_ * __uint_as_float(zz.y << 16), v3 = o[d0][4 * g_ + 3] * rl_ * __uint_as_float(zz.y & 0xffff0000u);                                       \
        u32x2 w_; w_.x = cvtpk(v0, v1); w_.y = cvtpk(v2, v3); *(u32x2*)(Gw + d0 * 32 + 8 * g_) = w_; } } } while (0)

__device__ __forceinline__ void fox_prime(const BlockRef& cur, char* lds, Seam& S) {
    const int tid = otid(), wid = __builtin_amdgcn_readfirstlane(tid >> 6), lane = tid & 63, r32 = lane & 31, hi = lane >> 5;
    const int sr = tid >> 4, sc = (tid & 15) * 8, asr = key_of_slot(sr), kws = KSWZ(sr, sc * 2); char* K_lds = lds + 2 * SHM_V;
    char* qhi = lds + LDS_QHI + wid * 4096 + lane * 16;
#pragma unroll
    for (int d0 = 0; d0 < 4; ++d0) S.qr[d0] = ld8(cur.Q + (size_t)(wid * QBLK + r32) * D + d0 * 16 + hi * 8);
#pragma unroll
    for (int d0 = 4; d0 < 8; ++d0) *(bf16x8*)(qhi + (d0 - 4) * 1024) = ld8(cur.Q + (size_t)(wid * QBLK + r32) * D + d0 * 16 + hi * 8);
    SLOAD_H(cur.K, cur.K + VOFF, cur.j0 * KVBLK); VMW(); SWRITE_HK(0);
    __syncthreads();
}
__device__ __forceinline__ int fox_block(const BlockRef& cur, const BlockRef& nxt, char* lds, Seam& S, const Queue& q) {
    const int tid = otid(), wid = __builtin_amdgcn_readfirstlane(tid >> 6), lane = tid & 63, r32 = lane & 31, hi = lane >> 5;
    const int j_lo = cur.j0, NT = (cur.P0 + QB) / KVBLK - j_lo;
    const int qlo = cur.P0 + wid * QBLK, qm = qlo + r32 - 32 * hi;
    char* V_lds = lds; char* K_lds = lds + 2 * SHM_V;
    float* bias = (float*)(lds + LDS_BIAS);
    volatile int* qw = (volatile int*)(lds + LDS_FLAGS + 32);
    if (tid == 0) qw[0] = q.fetch();
    { const float cref = cur.cum[cur.P0]; SBAR();
_Pragma("unroll 1")
      for (int s = j_lo * KVBLK + tid; s < cur.P0 + QB; s += NW * 64) bias[s] = cref - cur.cum[s];
      SBAR(); }
    __syncthreads();
    const int fetched = __builtin_amdgcn_readfirstlane(qw[0]);
    const float* bias_l = bias + hi * 32; char* qhi = lds + LDS_QHI + wid * 4096 + lane * 16;
    float m_reg = -1e30f, l_reg = 0; f32x16 o[4] = {};
    const int sr = tid >> 4, sc = (tid & 15) * 8, asr = key_of_slot(sr), vst0 = v_st(sr, sc), vst1 = v_st(32 + sr, sc), kws = KSWZ(sr, sc * 2);
    const int vb0 = (int)(uintptr_t)V_lds + v_rd_base(lane);
    const bf16* Kh = cur.K; const bf16* Vh = cur.K + VOFF;
#define RESC(a) do { if (__any((a) < 1.f)) { _Pragma("unroll") for (int d_ = 0; d_ < 4; ++d_) _Pragma("unroll") for (int r = 0; r < 16; ++r) o[d_][r] *= (a); } } while (0)
#define KBASE(t) ((j_lo + (t)) * KVBLK)
#define MASKT(P0_, P1_, t) do { const int kb_ = KBASE(t); if (kb_ + KVBLK - 1 > qlo) mask_tile(P0_, P1_, qm - kb_); } while (0)
    constexpr int NQL = 4;
#define SEAM_K0() do { VMWN(NQL); SWRITE_HK(0); SBAR(); } while (0)
    f32x16 pA0, pA1, pB0, pB1; float mnA, mnB, alA, alB; bf16x8 pa0, pa1, pa2, pa3;
    SWRITE_HV(0); SBAR();
    if (NT > 1) SLOAD_H(Kh, Vh, KBASE(1));
    SBAR(); qkt<0, true, true>(pA0, pA1, K_lds, r32, hi, S.qr, bias_l + KBASE(0), qhi);
    MASKT(pA0, pA1, 0); partialSM(pA0, pA1, m_reg, mnA, alA);
    if (NT > 1) { VMW(); SWRITE_H(1); }
    __syncthreads();
#define HALF_STEP(PX0, PX1, mnX, alX, PY0, PY1, alY, t, KB, VB, SB) do {                                                      \
        SBAR(); qkt<KB, true, true>(PX0, PX1, K_lds, r32, hi, S.qr, bias_l + KBASE(t), qhi);                                             \
        finishSM(PY0, PY1, alY, l_reg, pa0, pa1, pa2, pa3); SBAR();                                                           \
        if ((t) + 1 < NT) { SLOAD_H(Kh, Vh, KBASE((t) + 1)); SBAR(); }                                                        \
        pv_tile<VB>(o, vb0, pa0, pa1, pa2, pa3); MASKT(PX0, PX1, (t)); partialSM(PX0, PX1, m_reg, mnX, alX);                  \
        __syncthreads();                                                                                                      \
        if ((t) + 1 < NT) { VMW(); SWRITE_H(SB); }                                                                            \
        RESC(alX); __syncthreads(); } while (0)
    for (int t = 1; t + 1 < NT; t += 2) {
        HALF_STEP(pB0, pB1, mnB, alB, pA0, pA1, alA, t, 1, 0, 0);
        HALF_STEP(pA0, pA1, mnA, alA, pB0, pB1, alB, t + 1, 0, 1, 1);
    }
    const bool even = (NT & 1) == 0;
    if (even) { SBAR(); qkt<1, true, true>(pB0, pB1, K_lds, r32, hi, S.qr, bias_l + KBASE(NT - 1), qhi); SBAR(); }
    SLOAD_H(nxt.K, nxt.K + VOFF, nxt.j0 * KVBLK); SBAR();
#pragma unroll
    for (int d0 = 0; d0 < 4; ++d0) S.qr[d0] = ld8(nxt.Q + (size_t)(wid * QBLK + r32) * D + d0 * 16 + hi * 8);
    SBAR();
    finishSM(pA0, pA1, alA, l_reg, pa0, pa1, pa2, pa3); SBAR();
    pv_tile<0>(o, vb0, pa0, pa1, pa2, pa3);
    if (even) { MASKT(pB0, pB1, NT - 1); partialSM(pB0, pB1, m_reg, mnB, alB); __syncthreads(); RESC(alB);
        finishSM(pB0, pB1, alB, l_reg, pa0, pa1, pa2, pa3); SBAR(); pv_tile<1>(o, vb0, pa0, pa1, pa2, pa3); }
    SBAR(); SEAM_K0();
    bf16x8 qt[4];
#pragma unroll
    for (int d0 = 4; d0 < 8; ++d0) qt[d0 - 4] = ld8(nxt.Q + (size_t)(wid * QBLK + r32) * D + d0 * 16 + hi * 8);
    GATED_STORE(__builtin_amdgcn_rcpf(l_reg));
#pragma unroll
    for (int d0 = 0; d0 < 4; ++d0) *(bf16x8*)(qhi + d0 * 1024) = qt[d0];
    __syncthreads();
    return fetched;
#undef RESC
#undef MASKT
#undef SEAM_K0
#undef HALF_STEP
}
constexpr float SB_EXIT = 128.f;
__device__ __forceinline__ void sb_block(const BlockRef& cur, char* lds) {
    const int tid = otid(), wid = __builtin_amdgcn_readfirstlane(tid >> 6), lane = tid & 63, r32 = lane & 31, hi = lane >> 5;
    const int NT = (cur.P0 + QB) / KVBLK;
    const int qlo = cur.P0 + wid * QBLK, qm = qlo + r32 - 32 * hi - 1;
    char* V_lds = lds; char* K_lds = lds + 2 * SHM_V;
    volatile unsigned* flags = (volatile unsigned*)(lds + LDS_FLAGS);
    const int sr = tid >> 4, sc = (tid & 15) * 8, asr = key_of_slot(sr), vst0 = v_st(sr, sc), vst1 = v_st(32 + sr, sc), kws = KSWZ(sr, sc * 2);
    const int vb0 = (int)(uintptr_t)V_lds + v_rd_base(lane);
    const bf16* Kh = cur.K; const bf16* Vh = cur.K + VOFF;
    SeamSB S;
#pragma unroll
    for (int d0 = 0; d0 < 8; ++d0) S.qr[d0] = ld8(cur.Q + (size_t)(wid * QBLK + r32) * D + d0 * 16 + hi * 8);
    float R = 0.f; f32x16 o[4] = {};
    int j = NT - 1;
    SLOAD_H(Kh, Vh, j * KVBLK); VMW(); SWRITE_H(0);
    __syncthreads();
    f32x16 p0, p1; bf16x8 pa0, pa1, pa2, pa3;
#define SB_STEP(KB, NB, PAR) {                                                                                                 \
        const bool more = j > 0; const int kb_ = j * KVBLK;                                                                   \
        if (more) { SLOAD_H(Kh, Vh, kb_ - KVBLK); SBAR(); }                                                                   \
        if (kb_ <= qlo + QBLK - 2) {                                       \
            qkt<KB, false>(p0, p1, K_lds, r32, hi, S.qr, nullptr);                                                            \
            if (kb_ + KVBLK - 1 > qlo - 1) mask_tile(p0, p1, qm - kb_);                                                       \
            sb_math(p0, p1, R, hi, pa0, pa1, pa2, pa3); SBAR();                                                               \
            pv_tile<KB>(o, vb0, pa0, pa1, pa2, pa3); }                                                                        \
        const unsigned dn = __all(R < -SB_EXIT) ? 1u : 0u;                                                                    \
        if (lane == 0) flags[(PAR) * 8 + wid] = dn;                                                                           \
        if (more) { VMW(); SWRITE_H(NB); }                                                                                    \
        __syncthreads();                                                                                                      \
        unsigned alld = flags[(PAR) * 8 + (lane & 7)]; alld = __all(alld != 0u) ? 1u : 0u;                                     \
        --j; if (!more || alld) break; }
    for (;;) { SB_STEP(0, 1, 0) SB_STEP(1, 0, 1) }
#undef SB_STEP
    GATED_STORE(1.0f);
    __syncthreads();
}
#undef ROW
#undef VMW
#undef VMWN
#undef SLOAD_H
#undef SWRITE_HK
#undef SWRITE_HV
#undef SWRITE_H
#undef GATED_STORE
#undef PK4
}
constexpr int NB = 8, SEQ = 4096, DM = 1024, DI = 2048, NH = 16, DEPTH = 4, FOXC = 4 * DI + NH, SBC = 4 * DI;
constexpr int MTOT = NB * SEQ, NHALF = 2, BH = NB / NHALF, MH = BH * SEQ;
constexpr float LN_EPS = 1e-5f, ALPHA = 1.681792830507429f  , LOG2E = 1.4426950408889634f, QSCALE = 0.08838834764831845f * LOG2E;
constexpr size_t MiB = 1u << 20;
constexpr size_t WS_LOGF = 1 * MiB;
constexpr size_t WS_CUM = 3 * MiB;
constexpr size_t WS_QN = 4 * MiB;
constexpr size_t WS_JLO = 7 * MiB;
constexpr int CW_QUEUE = 4096;
constexpr size_t WS_WIN = 8 * MiB;
constexpr size_t WS_WOUT = 72 * MiB;
constexpr size_t WS_XB = 88 * MiB;
constexpr size_t WS_QKVZ = 152 * MiB;
constexpr size_t WS_G = 408 * MiB;
constexpr size_t WS_END = 472 * MiB;
constexpr int LDS_MISC = 131072, LDS_TOTAL = LDS_MISC + 1024;
static_assert(att::LDS_BYTES <= LDS_MISC && pg8::STAGE_BYTES <= LDS_MISC, "LDS map");

struct Params { const float* x; const float* fox_w_in; const float* fox_b_f; const float* fox_w_out; const float* sb_w_in; const float* sb_w_out; const float* ln_g; const float* ln_b; float* out; unsigned char* ws; };

typedef float f32x4 __attribute__((ext_vector_type(4)));
typedef unsigned u32x4 __attribute__((ext_vector_type(4)));
typedef unsigned u32x2 __attribute__((ext_vector_type(2)));
__device__ __forceinline__ float wave_sum(float v) {
#pragma unroll
    for (int o = 32; o >= 1; o >>= 1) v += __shfl_xor(v, o);
    return v;
}
__device__ __forceinline__ void transpose_tile(const float* W, int ld, int K, unsigned short* Wt, int k0, int n0, float* scr  ) {
    const int t = otid();
    { const int kk = t >> 3, nn = (t & 7) * 8; const float* src = W + (size_t)(k0 + kk) * ld + n0 + nn;
      const f32x4 a = *(const f32x4*)src, b = *(const f32x4*)(src + 4); float* d = scr + kk * 65 + nn;
      d[0] = a[0]; d[1] = a[1]; d[2] = a[2]; d[3] = a[3]; d[4] = b[0]; d[5] = b[1]; d[6] = b[2]; d[7] = b[3]; }
    __syncthreads();
    { const int nn = t >> 3, kk = (t & 7) * 8; float v[8];
#pragma unroll
      for (int j = 0; j < 8; ++j) v[j] = scr[(kk + j) * 65 + nn];
      u32x4 w; w.x = pg8::cvt_pk_bf16(v[0], v[1]); w.y = pg8::cvt_pk_bf16(v[2], v[3]); w.z = pg8::cvt_pk_bf16(v[4], v[5]); w.w = pg8::cvt_pk_bf16(v[6], v[7]);
      *(u32x4*)(Wt + (size_t)(n0 + nn) * K + k0 + kk) = w; }
    __syncthreads();
}
__device__ __forceinline__ void row_phase(const float* src, float* dstf, unsigned short* xb, float* logf2, const float* g, const float* bta, const float* wf  , const float* bf,
                                          int row_lo, int row_hi, unsigned char* lds) {
    const int tid = otid(), wid = tid >> 6, lane = tid & 63;
    float* wl = (float*)lds;
    if (wf) { for (int i = tid; i < 1024 * 4; i += 512) { const int c = i >> 2, j = i & 3; const f32x4 w = *(const f32x4*)(wf + (size_t)c * FOXC + 8192 + 4 * j);
                  wl[(4 * j + 0) * 1024 + c] = w[0]; wl[(4 * j + 1) * 1024 + c] = w[1]; wl[(4 * j + 2) * 1024 + c] = w[2]; wl[(4 * j + 3) * 1024 + c] = w[3]; }
              __syncthreads(); }
    for (int r = row_lo + obid() * 8 + wid; r < row_hi; r += ogrid() * 8) {
        f32x4 v[4];
#pragma unroll
        for (int i = 0; i < 4; ++i) v[i] = *(const f32x4*)(src + (size_t)r * DM + i * 256 + lane * 4);
        if (g) {
            float s = 0.f;
#pragma unroll
            for (int i = 0; i < 4; ++i) s += (v[i][0] + v[i][1]) + (v[i][2] + v[i][3]);
            const float mu = wave_sum(s) * (1.0f / DM); float q = 0.f;
#pragma unroll
            for (int i = 0; i < 4; ++i) { v[i] = v[i] - mu; q += (v[i][0] * v[i][0] + v[i][1] * v[i][1]) + (v[i][2] * v[i][2] + v[i][3] * v[i][3]); }
            const float rstd = 1.0f / sqrtf(wave_sum(q) * (1.0f / DM) + LN_EPS);
#pragma unroll
            for (int i = 0; i < 4; ++i) { const f32x4 gg = *(const f32x4*)(g + i * 256 + lane * 4), bb = *(const f32x4*)(bta + i * 256 + lane * 4);
                v[i] = v[i] * rstd * gg + bb; *(f32x4*)(dstf + (size_t)r * DM + i * 256 + lane * 4) = v[i]; }
        }
        if (xb) {
#pragma unroll
            for (int i = 0; i < 4; ++i) { u32x2 w; w.x = pg8::cvt_pk_bf16(v[i][0], v[i][1]); w.y = pg8::cvt_pk_bf16(v[i][2], v[i][3]); *(u32x2*)(xb + (size_t)r * DM + i * 256 + lane * 4) = w; }
        }
        if (wf) {
            float mine = 0.f;
#pragma unroll
            for (int h = 0; h < 16; ++h) { float a = 0.f;
#pragma unroll
                for (int i = 0; i < 4; ++i) { const f32x4 w = *(const f32x4*)(wl + h * 1024 + i * 256 + lane * 4); a += (v[i][0] * w[0] + v[i][1] * w[1]) + (v[i][2] * w[2] + v[i][3] * w[3]); }
                a = wave_sum(a); if (lane == h) mine = a; }
            if (lane < 16) { const float xx = mine + bf[lane]; const float ls = fminf(xx, 0.f) - log1pf(expf(-fabsf(xx))); logf2[(size_t)r * 16 + lane] = ls * LOG2E; }
        }
    }
}
__device__ __forceinline__ void cumsum_seq(const float* lf  , float* cum, float* scr  ) {
    const int tid = otid(), wid = tid >> 6, lane = tid & 63;
    float v[8]; float run = 0.f;
#pragma unroll
    for (int i = 0; i < 8; ++i) { run += lf[(size_t)(tid * 8 + i) * 16]; v[i] = run; }
    float inc = run;
#pragma unroll
    for (int o = 1; o < 64; o <<= 1) { const float t = __shfl_up(inc, o); if (lane >= o) inc += t; }
    if (lane == 63) scr[wid] = inc;
    __syncthreads();
    float off = inc - run;
    for (int w = 0; w < wid; ++w) off += scr[w];
#pragma unroll
    for (int i = 0; i < 8; ++i) cum[tid * 8 + i] = v[i] + off;
    __syncthreads();
}


#define LAS __attribute__((address_space(3)))
#define XB_TMO      128
#define XB_XCNT(j)  (256  + 64 * (j))
#define XB_XSUB(j)  (1280 + 64 * (j))
#define XB_XGEN(j)  (2304 + 64 * (j))
#define XB_TOP      3328
#define XB_TOPGEN   3392
#define XCD_BAR_WORDS 3456
#define XB_SPIN_CAP (1u << 20)
__device__ __forceinline__ unsigned xb_ld(unsigned* p)              { return __hip_atomic_load(p, __ATOMIC_RELAXED, __HIP_MEMORY_SCOPE_AGENT); }
__device__ __forceinline__ unsigned xb_add(unsigned* p, unsigned v) { return __hip_atomic_fetch_add(p, v, __ATOMIC_RELAXED, __HIP_MEMORY_SCOPE_AGENT); }
__device__ __forceinline__ unsigned xb_xcc_id() { return (unsigned)__builtin_amdgcn_s_getreg((3 << 11) | 20) & 0xFu; }
#define XB_SPIN(cond, bar) do { unsigned _sp = 0; while (cond) { __builtin_amdgcn_s_sleep(1); \
    if ((++_sp & 255u) == 0u) { if (xb_ld(&(bar)[XB_TMO])) break; if (_sp > XB_SPIN_CAP) { atomicAdd(&(bar)[XB_TMO], 1u); break; } } } } while (0)
__device__ __forceinline__ void xcd_barrier_complete(unsigned* bar, unsigned x, unsigned& nloc, unsigned& nx) {
    const unsigned G = gridDim.x * gridDim.y * gridDim.z;
    unsigned sum, cnt, mine, sp = 0u;
    for (;;) {
        sum = 0u; cnt = 0u; mine = 0u;
#pragma unroll
        for (unsigned j = 0; j < 16; ++j) { const unsigned c = xb_ld(&bar[XB_XCNT(j)]); sum += c; cnt += (c > 0u) ? 1u : 0u; mine = (j == x) ? c : mine; }
        if (sum == G) break;
        __builtin_amdgcn_s_sleep(1);
        if ((++sp & 255u) == 0u) { if (xb_ld(&bar[XB_TMO])) break; if (sp > XB_SPIN_CAP) { atomicAdd(&bar[XB_TMO], 1u); break; } }
    }
    nloc = mine > 0u ? mine : 1u; nx = cnt > 0u ? cnt : 1u;
}
__device__ __forceinline__ void xcd_barrier(unsigned* bar, volatile LAS unsigned* st) {
    asm volatile("s_waitcnt vmcnt(0)" ::: "memory");
    __syncthreads();
    if (threadIdx.x == 0) {
        const unsigned x = xb_xcc_id();
        __builtin_amdgcn_s_waitcnt(0);
        unsigned nloc = st[0], nx = st[1];
        if (nloc == 0u) { xcd_barrier_complete(bar, x, nloc, nx); st[0] = nloc; st[1] = nx; }
        const unsigned old = xb_add(&bar[XB_XSUB(x)], 1u);
        const unsigned gen = old / nloc;
        if (old + 1u == (gen + 1u) * nloc) {
            __builtin_amdgcn_fence(__ATOMIC_RELEASE, "agent");
            asm volatile("s_waitcnt vmcnt(0)" ::: "memory");
            const unsigned og = xb_add(&bar[XB_TOP], 1u);
            const unsigned tg = og / nx;
            if (og + 1u == (tg + 1u) * nx) xb_add(&bar[XB_TOPGEN], 1u);
            else XB_SPIN(xb_ld(&bar[XB_TOPGEN]) == tg, bar);
            __builtin_amdgcn_fence(__ATOMIC_ACQUIRE, "agent");
            xb_add(&bar[XB_XGEN(x)], 1u);
            asm volatile("s_waitcnt vmcnt(0)" ::: "memory");
        } else {
            XB_SPIN(xb_ld(&bar[XB_XGEN(x)]) == gen, bar);
            __builtin_amdgcn_fence(__ATOMIC_ACQUIRE, "agent");
            asm volatile("s_waitcnt vmcnt(0)" ::: "memory");
        }
    }
    __syncthreads();
}


#define WS_PTRS(p) unsigned char* ws = (p).ws; float* logf2 = (float*)(ws + WS_LOGF); float* cum = (float*)(ws + WS_CUM); unsigned short* win = (unsigned short*)(ws + WS_WIN); unsigned short* wout = (unsigned short*)(ws + WS_WOUT); \
    unsigned short* xb = (unsigned short*)(ws + WS_XB); unsigned short* qkvz = (unsigned short*)(ws + WS_QKVZ); unsigned short* gbuf = (unsigned short*)(ws + WS_G);       \
    (void)logf2; (void)cum; (void)win; (void)wout; (void)xb; (void)qkvz; (void)gbuf
constexpr size_t PLANE = (size_t)MH * DI;
__device__ __forceinline__ int vcu_of(int G, int bx) { return (G % 8 == 0) ? (bx % 8) * (G / 8) + bx / 8 : bx; }

__device__ __forceinline__ void ph_prologue(const Params& p, unsigned char* lds) {
    WS_PTRS(p); const int G = ogrid(), bx = obid();
    constexpr int T_IN = (DM / 64) * (8192 / 64), T_OUT = (DI / 64) * (DM / 64), T_L = T_IN + T_OUT;
    for (int t = bx; t < DEPTH * T_L; t += G) {
        const int l = t / T_L, u = t % T_L, slot = l >> 1; const bool fox = (l & 1) == 0;
        if (u < T_IN) { const float* W = fox ? p.fox_w_in + (size_t)slot * DM * FOXC : p.sb_w_in + (size_t)slot * DM * SBC;
            transpose_tile(W, fox ? FOXC : SBC, DM, win + (size_t)l * 8192 * DM, (u % (DM / 64)) * 64, (u / (DM / 64)) * 64, (float*)lds); }
        else { const int uu = u - T_IN; const float* W = (fox ? p.fox_w_out : p.sb_w_out) + (size_t)slot * DI * DM;
            transpose_tile(W, DM, DI, wout + (size_t)l * DM * DI, (uu % (DI / 64)) * 64, (uu / (DI / 64)) * 64, (float*)lds); }
    }
    row_phase(p.x, nullptr, xb, logf2, nullptr, nullptr, p.fox_w_in, p.fox_b_f, 0, MTOT, lds);
}
__device__ __forceinline__ void ph_inproj(const Params& p, int hf, int l, unsigned char* lds) {
    WS_PTRS(p); const int G = ogrid(), bx = obid(); const bool fox = (l & 1) == 0;
    if (fox && bx < BH * NH) { const int b = bx / NH, h = bx % NH;
        cumsum_seq(logf2 + ((size_t)(hf * BH + b) * SEQ) * 16 + h, cum + (size_t)bx * SEQ, (float*)(lds + LDS_MISC)); }
    pg8::Gemm g{xb + (size_t)hf * MH * DM, win + (size_t)l * 8192 * DM, MH, 8192, DM}; pg8::StaticOrder S; S.init(MH, 8192, G, bx);
    pg8::EpiQKVZ E{qkvz, PLANE, QSCALE};
    pg8::gemm_phase<pg8::EpiQKVZ, pg8::StaticOrder, true, true>((PG8_LAS unsigned char*)lds, g, S, E);
}
__device__ __forceinline__ att::BlockRef blk_ref(unsigned short* qkvz, unsigned short* gbuf, const float* cum, int bh, int qb) {
    const size_t ho = (size_t)bh * SEQ * 128, qo = ho + (size_t)qb * att::QB * 128;
    static_assert(att::VOFF == PLANE, "plane stride"); att::BlockRef r; r.Q = qkvz + qo; r.K = qkvz + PLANE + ho;
    r.G = gbuf + ((size_t)(bh / NH) * SEQ + (size_t)qb * att::QB) * DI + (bh % NH) * 128; r.cum = cum + (size_t)bh * SEQ; r.P0 = qb * att::QB; r.j0 = 0; return r;
}
constexpr float FOX_T = 36.f;
constexpr int NROWS = BH * NH * SEQ;
__device__ __forceinline__ void ph_fox_norms(const Params& p) {
    WS_PTRS(p); const int tid = otid(), wid = tid >> 6, lane = tid & 63, sub = lane >> 4, c = lane & 15;
    float* qn = (float*)(ws + WS_QN); float* kn = qn + NROWS; float* dg = kn + NROWS;
    const int nw = ogrid() * 8;
    for (int base = (obid() * 8 + wid) * 4; base < NROWS; base += nw * 4) {
        const int row = base + sub;
        const att::bf16x8 qv = *(const att::bf16x8*)(qkvz + (size_t)row * 128 + c * 8), kv = *(const att::bf16x8*)(qkvz + PLANE + (size_t)row * 128 + c * 8);
        float qq = 0.f, kk = 0.f, qk = 0.f;
#pragma unroll
        for (int i = 0; i < 8; ++i) { const float a = att::bf2f((unsigned short)qv[i]), b = att::bf2f((unsigned short)kv[i]); qq += a * a; kk += b * b; qk += a * b; }
#pragma unroll
        for (int o = 1; o < 16; o <<= 1) { qq += __shfl_xor(qq, o); kk += __shfl_xor(kk, o); qk += __shfl_xor(qk, o); }
        if (c == 0) { qn[row] = sqrtf(qq) * 1.0001f; kn[row] = sqrtf(kk) * 1.0001f; dg[row] = qk; }
    }
}
__device__ __forceinline__ void ph_fox_jlo(const Params& p) {
    WS_PTRS(p); const int tid = otid(), wid = tid >> 6, lane = tid & 63;
    const float* qn = (const float*)(ws + WS_QN); const float* kn = qn + NROWS; const float* dg = kn + NROWS; int* jlo = (int*)(ws + WS_JLO);
    constexpr int NQB = SEQ / att::QB, NBLK = BH * NH * NQB;
    for (int id = obid() * 8 + wid; id < NBLK; id += ogrid() * 8) {
        const int bh = id / NQB, qb = id % NQB, P0 = qb * att::QB; const size_t ro = (size_t)bh * SEQ;
        float qmax = 0.f, dmin = 1e30f;
#pragma unroll
        for (int i = 0; i < 4; ++i) { qmax = fmaxf(qmax, qn[ro + P0 + lane + 64 * i]); dmin = fminf(dmin, dg[ro + P0 + lane + 64 * i]); }
#pragma unroll
        for (int o = 32; o >= 1; o >>= 1) { qmax = fmaxf(qmax, __shfl_xor(qmax, o)); dmin = fminf(dmin, __shfl_xor(dmin, o)); }
        const float cref = cum[ro + P0], thr = dmin - FOX_T - 0.5f;
        int first = P0;
        for (int s = lane; s < P0; s += 64) { const float bound = qmax * kn[ro + s] + (cref - cum[ro + s]); if (!(bound < thr)) first = min(first, s); }
#pragma unroll
        for (int o = 32; o >= 1; o >>= 1) first = min(first, __shfl_xor(first, o));
        if (lane == 0) jlo[id] = first / att::KVBLK;
    }
}
__device__ __forceinline__ att::BlockRef fox_item(unsigned short* qkvz, unsigned short* gbuf, const float* cum, const int* jlo, int item) {
    constexpr int NQB = SEQ / att::QB; const int xq = item >> 7, i = item & 127, bh = xq * 8 + (i & 7), qb = NQB - 1 - (i >> 3);
    att::BlockRef r = blk_ref(qkvz, gbuf, cum, bh, qb); r.j0 = __builtin_amdgcn_readfirstlane(jlo[bh * NQB + qb]); return r;
}
__device__ __forceinline__ void ph_fox(const Params& p, int phase_idx, unsigned char* lds) {
    WS_PTRS(p); const int* jlo = (const int*)(ws + WS_JLO);
    static_assert(BH * NH == 64 && SEQ / att::QB == 16, "queue geometry: 8 queues x 8 head-sequences x 16 blocks");
    att::Queue q; q.ctr = (unsigned*)ws + CW_QUEUE + phase_idx * 128; q.x = (int)(xb_xcc_id() & 7u); q.nperq = 128;
    volatile int* qw = (volatile int*)(lds + att::LDS_FLAGS + 32);
    if (otid() == 0) { qw[0] = q.fetch(); qw[1] = q.fetch(); }
    __syncthreads();
    int icur = __builtin_amdgcn_readfirstlane(qw[0]), inxt = __builtin_amdgcn_readfirstlane(qw[1]);
    __syncthreads();
    if (icur < 0) return;
    att::BlockRef cur = fox_item(qkvz, gbuf, cum, jlo, icur); att::Seam S;
    att::fox_prime(cur, (char*)lds, S);
    for (;;) {
        const bool last = inxt < 0;
        const att::BlockRef nxt = last ? cur : fox_item(qkvz, gbuf, cum, jlo, inxt);
        const int f = att::fox_block(cur, nxt, (char*)lds, S, q);
        if (last) break;
        cur = nxt; inxt = f;
    }
}
__device__ __forceinline__ void ph_sb(const Params& p, unsigned char* lds) {
    WS_PTRS(p); const int G = ogrid(), vcu = vcu_of(G, obid());
    constexpr int NQB = SEQ / att::QB, TOTAL = BH * NH * NQB;
    for (int L = vcu; L < TOTAL; L += G) { const att::BlockRef r = blk_ref(qkvz, gbuf, cum, L / NQB, L % NQB); att::sb_block(r, (char*)lds); }
}
__device__ __forceinline__ void ph_outproj(const Params& p, int hf, int l, unsigned char* lds) {
    WS_PTRS(p); const int G = ogrid(), bx = obid(); const size_t ro = (size_t)hf * MH * DM;
    pg8::Gemm g{gbuf, wout + (size_t)l * DM * DI, MH, DM, DI}; pg8::StaticOrder S; S.init(MH, DM, G, bx);
    pg8::EpiRes E{(l == 0 ? p.x : p.out) + ro, p.out + ro, ALPHA};
    pg8::gemm_phase<pg8::EpiRes, pg8::StaticOrder, true, true>((PG8_LAS unsigned char*)lds, g, S, E);
}
__device__ __forceinline__ void ph_rows(const Params& p, int hf, int l, unsigned char* lds) {
    WS_PTRS(p); const bool nfox = (l + 1 < DEPTH) && (((l + 1) & 1) == 0); const int ns = (l + 1) >> 1;
    row_phase(p.out, p.out, (l + 1 < DEPTH) ? xb : nullptr, logf2, p.ln_g + l * DM, p.ln_b + l * DM,
              nfox ? p.fox_w_in + (size_t)ns * DM * FOXC : nullptr, nfox ? p.fox_b_f + ns * NH : nullptr, hf * MH, hf * MH + MH, lds);
}


#ifndef N_LAUNCH_MODE
#define N_LAUNCH_MODE 1
#endif
#if N_LAUNCH_MODE == 0
__global__ void __launch_bounds__(512, 2) k_prologue(Params p) { extern __shared__ __attribute__((aligned(16))) unsigned char lds[]; ph_prologue(p, lds); }
__global__ void __launch_bounds__(512, 2) k_inproj(Params p, int hf, int l) { extern __shared__ __attribute__((aligned(16))) unsigned char lds[]; ph_inproj(p, hf, l, lds); }
__global__ void __launch_bounds__(512, 2) k_foxn(Params p) { ph_fox_norms(p); }
__global__ void __launch_bounds__(512, 2) k_foxj(Params p) { ph_fox_jlo(p); }
__global__ void __launch_bounds__(512, 2) k_fox(Params p, int idx) { extern __shared__ __attribute__((aligned(16))) unsigned char lds[]; ph_fox(p, idx, lds); }
__global__ void __launch_bounds__(512, 2) k_sb(Params p) { extern __shared__ __attribute__((aligned(16))) unsigned char lds[]; ph_sb(p, lds); }
__global__ void __launch_bounds__(512, 2) k_outproj(Params p, int hf, int l) { extern __shared__ __attribute__((aligned(16))) unsigned char lds[]; ph_outproj(p, hf, l, lds); }
__global__ void __launch_bounds__(512, 2) k_rows(Params p, int hf, int l) { extern __shared__ __attribute__((aligned(16))) unsigned char lds[]; ph_rows(p, hf, l, lds); }
#else
#ifndef REP_SYNC
#define REP_SYNC 1
#endif
#ifndef REP_INPROJ
#define REP_INPROJ 1
#endif
#ifndef REP_FOX
#define REP_FOX 1
#endif
#ifndef REP_SB
#define REP_SB 1
#endif
#define GSYNC() do { for (int rs_ = 0; rs_ < REP_SYNC; ++rs_) { PENV(); xcd_barrier((unsigned*)p.ws, (volatile LAS unsigned*)(lds + LDS_MISC + 512)); } } while (0)
#define PENV() const __attribute__((address_space(4))) Params* pp_ = (const __attribute__((address_space(4))) Params*)__builtin_amdgcn_kernarg_segment_ptr(); asm volatile("" : "+s"(pp_)); Params p; p.x = pp_->x; p.fox_w_in = pp_->fox_w_in; p.fox_b_f = pp_->fox_b_f; p.fox_w_out = pp_->fox_w_out; p.sb_w_in = pp_->sb_w_in; p.sb_w_out = pp_->sb_w_out; p.ln_g = pp_->ln_g; p.ln_b = pp_->ln_b; p.out = pp_->out; p.ws = pp_->ws
__global__ void __launch_bounds__(512, 2) fox_sb_mega(Params p_unused) {
    extern __shared__ __attribute__((aligned(16))) unsigned char lds[];
    cg::grid_group grid = cg::this_grid();
    if (threadIdx.x < 2) ((volatile LAS unsigned*)(lds + LDS_MISC + 512))[threadIdx.x] = 0u;
    __syncthreads();
    { PENV(); if (threadIdx.x == 0) (void)xb_add((unsigned*)p.ws + XB_XCNT(xb_xcc_id()), 1u); }
    { PENV(); ph_prologue(p, lds); }
    grid.sync();
    GSYNC();
    for (int hf = 0; hf < NHALF; ++hf)
        for (int l = 0; l < DEPTH; ++l) {
            { PENV(); ph_inproj(p, hf, l, lds); }
#if REP_INPROJ == 2
            { PENV(); ph_inproj(p, hf, l, lds); }
#endif
            GSYNC();
            if ((l & 1) == 0) { { PENV(); ph_fox_norms(p); } GSYNC(); { PENV(); ph_fox_jlo(p); } GSYNC(); { PENV(); ph_fox(p, hf * DEPTH + l, lds); }
            } else { { PENV(); ph_sb(p, lds); }
#if REP_SB == 2
                { PENV(); ph_sb(p, lds); }
#endif
            }
            GSYNC();
            { PENV(); ph_outproj(p, hf, l, lds); }
            GSYNC();
            { PENV(); ph_rows(p, hf, l, lds); }
            GSYNC();
        }
}
#endif

extern "C" void kernel_launch(void* const* d_in, const int* in_sizes, int n_in, void* d_out, int out_size, void* d_ws, size_t ws_size, hipStream_t stream) {
    static int grid = 0;
    if (grid == 0) {
        if (n_in != 8 || in_sizes[0] != MTOT * DM || out_size != MTOT * DM || ws_size < WS_END) { fprintf(stderr, "kernel_launch: unexpected shapes (n_in %d, in0 %d, out %d, ws %zu)\n", n_in, n_in > 0 ? in_sizes[0] : -1, out_size, ws_size); grid = -1; return; }
        int dev = 0, cus = 0;
        (void)hipGetDevice(&dev); (void)hipDeviceGetAttribute(&cus, hipDeviceAttributeMultiprocessorCount, dev);
#if N_LAUNCH_MODE == 0
        bool ok = hipFuncSetAttribute((const void*)k_prologue, hipFuncAttributeMaxDynamicSharedMemorySize, LDS_TOTAL) == hipSuccess;
        ok = ok && hipFuncSetAttribute((const void*)k_inproj, hipFuncAttributeMaxDynamicSharedMemorySize, LDS_TOTAL) == hipSuccess;
        ok = ok && hipFuncSetAttribute((const void*)k_fox, hipFuncAttributeMaxDynamicSharedMemorySize, LDS_TOTAL) == hipSuccess;
        ok = ok && hipFuncSetAttribute((const void*)k_sb, hipFuncAttributeMaxDynamicSharedMemorySize, LDS_TOTAL) == hipSuccess;
        ok = ok && hipFuncSetAttribute((const void*)k_outproj, hipFuncAttributeMaxDynamicSharedMemorySize, LDS_TOTAL) == hipSuccess;
        ok = ok && hipFuncSetAttribute((const void*)k_rows, hipFuncAttributeMaxDynamicSharedMemorySize, LDS_TOTAL) == hipSuccess;
        if (!ok) { fprintf(stderr, "kernel_launch: hipFuncSetAttribute failed\n"); grid = -1; return; }
#else
        int per_cu = 0;
        if (hipFuncSetAttribute((const void*)fox_sb_mega, hipFuncAttributeMaxDynamicSharedMemorySize, LDS_TOTAL) != hipSuccess) { fprintf(stderr, "kernel_launch: hipFuncSetAttribute failed\n"); grid = -1; return; }
        if (hipOccupancyMaxActiveBlocksPerMultiprocessor(&per_cu, (const void*)fox_sb_mega, 512, LDS_TOTAL) != hipSuccess || per_cu < 1) { fprintf(stderr, "kernel_launch: occupancy query says %d\n", per_cu); }
        (void)hipGetLastError();
#endif
        grid = cus > 0 ? cus : 256;
    }
    if (grid < 0) return;
    Params p{};
    p.x = (const float*)d_in[0]; p.fox_w_in = (const float*)d_in[1]; p.fox_b_f = (const float*)d_in[2]; p.fox_w_out = (const float*)d_in[3];
    p.sb_w_in = (const float*)d_in[4]; p.sb_w_out = (const float*)d_in[5]; p.ln_g = (const float*)d_in[6]; p.ln_b = (const float*)d_in[7];
    p.out = (float*)d_out; p.ws = (unsigned char*)d_ws;
#if 1
    if (hipMemsetAsync(d_ws, 0, 32768, stream) != hipSuccess) { fprintf(stderr, "kernel_launch: memset failed\n"); return; }
#endif
#if N_LAUNCH_MODE == 0
    k_prologue<<<grid, 512, LDS_TOTAL, stream>>>(p);
    for (int hf = 0; hf < NHALF; ++hf)
        for (int l = 0; l < DEPTH; ++l) {
            k_inproj<<<grid, 512, LDS_TOTAL, stream>>>(p, hf, l);
            if ((l & 1) == 0) { k_foxn<<<grid, 512, 0, stream>>>(p); k_foxj<<<grid, 512, 0, stream>>>(p); k_fox<<<grid, 512, LDS_TOTAL, stream>>>(p, hf * DEPTH + l); } else k_sb<<<grid, 512, LDS_TOTAL, stream>>>(p);
            k_outproj<<<grid, 512, LDS_TOTAL, stream>>>(p, hf, l);
            k_rows<<<grid, 512, LDS_TOTAL, stream>>>(p, hf, l);
        }
#else
    void* args[] = {&p};
    hipError_t e = hipLaunchCooperativeKernel((const void*)fox_sb_mega, dim3(grid), dim3(512), args, LDS_TOTAL, stream);
    if (e != hipSuccess) fprintf(stderr, "cooperative launch failed: %s (grid %d)\n", hipGetErrorString(e), grid);
#endif
}
```
